# Optimizing an MI355X kernel written in HIP

```python
import jax, jax.numpy as jnp
from jax import lax
import numpy as np

D_MODEL = 1024
BATCH = 4
SEQ = 4096
DEPTH = 1

LRU_WIDTH = D_MODEL // 2
LRU_HEADS = 8
LRU_HEAD_DIM = LRU_WIDTH // LRU_HEADS
CONV_WIDTH = 4
LRU_C = 8.0
POOL_WIDTH = D_MODEL // 2
POOL_WINDOWS = (2, 4, 8, 16)
POOL_GROUPS = len(POOL_WINDOWS)
POOL_GROUP_DIM = POOL_WIDTH // POOL_GROUPS
MIX_WIDTH = LRU_WIDTH + POOL_WIDTH
IN_WIDTH = 2 * LRU_WIDTH + POOL_WIDTH
N_EXPERTS = 32
TOP_K = 4
D_EXPERT = D_MODEL
SWIGLU_LIMIT = 7.0
SWIGLU_ALPHA = 1.702
EXPERT_BLOCK = 256
NORM_EPS = 1e-6

kernel_name = "hybrid_rglru_pool_moe_adaln"


def rms_norm(x, g):
    x32 = x.astype(jnp.float32)
    y = x32 * lax.rsqrt(jnp.mean(x32 * x32, axis=-1, keepdims=True) + NORM_EPS)
    return (y * g.astype(jnp.float32)).astype(x.dtype)


def modulate(h, shift, scale):
    return h * (1.0 + scale[:, None, :]) + shift[:, None, :]


def causal_depthwise_conv(x, w, b):
    S = x.shape[1]
    xp = jnp.pad(x, ((0, 0), (CONV_WIDTH - 1, 0), (0, 0)))
    y = b
    for k in range(CONV_WIDTH):
        s0 = CONV_WIDTH - 1 - k
        y = y + xp[:, s0:s0 + S] * w[k]
    return y


def _lin_combine(e1, e2):
    a1, b1 = e1
    a2, b2 = e2
    return a1 * a2, a2 * b1 + b2


def rg_lru(x, gate_a_w, gate_a_b, gate_x_w, gate_x_b, lam):
    B, S, _ = x.shape
    xh = x.reshape(B, S, LRU_HEADS, LRU_HEAD_DIM)
    r = jax.nn.sigmoid(jnp.einsum('bshi,hij->bshj', xh, gate_a_w).reshape(B, S, LRU_WIDTH) + gate_a_b)
    i = jax.nn.sigmoid(jnp.einsum('bshi,hij->bshj', xh, gate_x_w).reshape(B, S, LRU_WIDTH) + gate_x_b)
    log_a = -LRU_C * r.astype(jnp.float32) * jax.nn.softplus(-lam.astype(jnp.float32))
    a = jnp.exp(log_a)
    mult = jnp.sqrt(-jnp.expm1(2.0 * log_a))
    bterm = mult * (i * x).astype(jnp.float32)
    _, h = lax.associative_scan(_lin_combine, (a, bterm), axis=1)
    return h.astype(x.dtype)


def causal_pool_mixer(x, pool_w, pool_b, pool_scale):
    B, S, C = x.shape
    x32 = x.astype(jnp.float32)
    cs = jnp.pad(jnp.cumsum(x32, axis=1), ((0, 0), (1, 0), (0, 0)))
    t = jnp.arange(S)
    outs = []
    for g, w in enumerate(POOL_WINDOWS):
        lo, hi = g * POOL_GROUP_DIM, (g + 1) * POOL_GROUP_DIM
        csg = cs[..., lo:hi]
        lagged = jnp.pad(csg[:, :S + 1 - w], ((0, 0), (w - 1, 0), (0, 0)))
        count = jnp.minimum(t + 1, w).astype(jnp.float32)[None, :, None]
        outs.append((csg[:, 1:] - lagged) / count - x32[..., lo:hi])
    p = jnp.concatenate(outs, axis=-1).reshape(B, S, POOL_GROUPS, POOL_GROUP_DIM)
    y = jnp.einsum('bsgc,gcd->bsgd', p, pool_w.astype(jnp.float32)).reshape(B, S, C) + pool_b
    return (y * pool_scale).astype(x.dtype)


def clamped_swiglu(u):
    glu = jnp.minimum(u[..., ::2], SWIGLU_LIMIT)
    lin = jnp.clip(u[..., 1::2], -SWIGLU_LIMIT, SWIGLU_LIMIT)
    return glu * jax.nn.sigmoid(SWIGLU_ALPHA * glu) * (lin + 1.0)


def moe_ffn(h, router_w, router_b, w1, b1, w2, b2):
    B, S, D = h.shape
    T = B * S
    ht = h.reshape(T, D)
    logits = (ht @ router_w + router_b).astype(jnp.float32)
    top_val, top_idx = lax.top_k(logits, TOP_K)
    gates = jax.nn.softmax(top_val, axis=-1)
    flat_e = top_idx.reshape(-1).astype(jnp.int32)
    flat_tok = jnp.arange(T * TOP_K, dtype=jnp.int32) // TOP_K
    flat_w = gates.reshape(-1)
    order = jnp.argsort(flat_e)
    sorted_e = flat_e[order]
    counts = jnp.bincount(flat_e, length=N_EXPERTS).astype(jnp.int32)
    starts = jnp.cumsum(counts) - counts
    padded = (counts + EXPERT_BLOCK - 1) // EXPERT_BLOCK * EXPERT_BLOCK
    pad_ends = jnp.cumsum(padded)
    pad_starts = pad_ends - padded
    rank = jnp.arange(T * TOP_K, dtype=jnp.int32) - starts[sorted_e]
    dest = pad_starts[sorted_e] + rank
    n_blocks = -(-(T * TOP_K) // EXPERT_BLOCK) + N_EXPERTS
    cap = n_blocks * EXPERT_BLOCK
    tok_buf = jnp.full((cap,), T, dtype=jnp.int32).at[dest].set(flat_tok[order])
    w_buf = jnp.zeros((cap,), jnp.float32).at[dest].set(flat_w[order])
    block_start = jnp.arange(n_blocks, dtype=jnp.int32) * EXPERT_BLOCK
    block_e = jnp.minimum(jnp.searchsorted(pad_ends, block_start, side='right'), N_EXPERTS - 1)
    h_pad = jnp.concatenate([ht, jnp.zeros((1, D), ht.dtype)], axis=0)

    def expert_block(args):
        idx, wt, e = args
        xb = h_pad[idx]
        u = xb @ w1[e] + b1[e]
        y = clamped_swiglu(u) @ w2[e] + b2[e]
        return y.astype(jnp.float32) * wt[:, None]

    y = lax.map(expert_block, (tok_buf.reshape(n_blocks, EXPERT_BLOCK),
                               w_buf.reshape(n_blocks, EXPERT_BLOCK), block_e))
    out = jnp.zeros((T + 1, D), jnp.float32).at[tok_buf].add(y.reshape(cap, D))[:T]
    return out.reshape(B, S, D).astype(h.dtype)


def setup_inputs(seed: int = 0) -> dict:
    key = jax.random.key(seed)
    ks = jax.random.split(key, 28)
    f32 = jnp.float32
    nrm = lambda k, shape, s: jax.random.normal(k, shape, f32) * s
    gain = lambda k: 1.0 + 0.05 * jax.random.normal(k, (DEPTH, D_MODEL), f32)
    u = jax.random.uniform(ks[13], (DEPTH, LRU_WIDTH), f32, minval=0.9, maxval=0.999)
    p = u ** (1.0 / LRU_C)
    lru_lambda = jnp.log(p) - jnp.log1p(-p)
    return {
        "x": nrm(ks[0], (BATCH, SEQ, D_MODEL), 1.0),
        "c": nrm(ks[1], (BATCH, D_MODEL), 1.0),
        "w_ada": nrm(ks[2], (DEPTH, D_MODEL, 6 * D_MODEL), D_MODEL ** -0.5),
        "b_ada": nrm(ks[3], (DEPTH, 6 * D_MODEL), 0.02),
        "norm_mix_pre": gain(ks[4]),
        "norm_mix_post": gain(ks[5]),
        "w_in": nrm(ks[6], (DEPTH, D_MODEL, IN_WIDTH), D_MODEL ** -0.5),
        "conv_w": nrm(ks[7], (DEPTH, CONV_WIDTH, LRU_WIDTH), CONV_WIDTH ** -0.5),
        "conv_b": nrm(ks[8], (DEPTH, LRU_WIDTH), 0.02),
        "gate_a_w": nrm(ks[9], (DEPTH, LRU_HEADS, LRU_HEAD_DIM, LRU_HEAD_DIM), LRU_HEAD_DIM ** -0.5),
        "gate_a_b": nrm(ks[10], (DEPTH, LRU_WIDTH), 0.02),
        "gate_x_w": nrm(ks[11], (DEPTH, LRU_HEADS, LRU_HEAD_DIM, LRU_HEAD_DIM), LRU_HEAD_DIM ** -0.5),
        "gate_x_b": nrm(ks[12], (DEPTH, LRU_WIDTH), 0.02),
        "lru_lambda": lru_lambda,
        "pool_w": nrm(ks[14], (DEPTH, POOL_GROUPS, POOL_GROUP_DIM, POOL_GROUP_DIM), POOL_GROUP_DIM ** -0.5),
        "pool_b": nrm(ks[15], (DEPTH, POOL_WIDTH), 0.02),
        "pool_scale": 1.0 + 0.05 * jax.random.normal(ks[16], (DEPTH, POOL_WIDTH), f32),
        "w_out": nrm(ks[17], (DEPTH, MIX_WIDTH, D_MODEL), MIX_WIDTH ** -0.5),
        "norm_ffn_pre": gain(ks[18]),
        "norm_ffn_post": gain(ks[19]),
        "router_w": nrm(ks[20], (DEPTH, D_MODEL, N_EXPERTS), D_MODEL ** -0.5),
        "router_b": nrm(ks[21], (DEPTH, N_EXPERTS), 0.01),
        "expert_w1": nrm(ks[22], (DEPTH, N_EXPERTS, D_MODEL, 2 * D_EXPERT), D_MODEL ** -0.5),
        "expert_b1": nrm(ks[23], (DEPTH, N_EXPERTS, 2 * D_EXPERT), 0.02),
        "expert_w2": nrm(ks[24], (DEPTH, N_EXPERTS, D_EXPERT, D_MODEL), D_EXPERT ** -0.5),
        "expert_b2": nrm(ks[25], (DEPTH, N_EXPERTS, D_MODEL), 0.02),
    }


def reference(x, c, w_ada, b_ada, norm_mix_pre, norm_mix_post, w_in, conv_w, conv_b,
              gate_a_w, gate_a_b, gate_x_w, gate_x_b, lru_lambda, pool_w, pool_b, pool_scale,
              w_out, norm_ffn_pre, norm_ffn_post, router_w, router_b,
              expert_w1, expert_b1, expert_w2, expert_b2):
    c_act = jax.nn.silu(c)
    for l in range(DEPTH):
        mod = c_act @ w_ada[l] + b_ada[l]
        shift_m, scale_m, gate_m, shift_f, scale_f, gate_f = jnp.split(mod, 6, axis=-1)

        h = modulate(rms_norm(x, norm_mix_pre[l]), shift_m, scale_m)
        u = h @ w_in[l]
        xa = u[..., :LRU_WIDTH]
        ga = u[..., LRU_WIDTH:2 * LRU_WIDTH]
        xb = u[..., 2 * LRU_WIDTH:]
        xa = causal_depthwise_conv(xa, conv_w[l], conv_b[l])
        ya = rg_lru(xa, gate_a_w[l], gate_a_b[l], gate_x_w[l], gate_x_b[l], lru_lambda[l]) * jax.nn.gelu(ga)
        yb = causal_pool_mixer(xb, pool_w[l], pool_b[l], pool_scale[l])
        mix = jnp.concatenate([ya, yb], axis=-1) @ w_out[l]
        x = x + gate_m[:, None, :] * rms_norm(mix, norm_mix_post[l])

        h = modulate(rms_norm(x, norm_ffn_pre[l]), shift_f, scale_f)
        f = moe_ffn(h, router_w[l], router_b[l], expert_w1[l], expert_b1[l], expert_w2[l], expert_b2[l])
        x = x + gate_f[:, None, :] * rms_norm(f, norm_ffn_post[l])
    return x
```

```cpp
#include <hip/hip_runtime.h>
#include <cstdio>
#include <cstdint>

#ifndef MK_N_LAUNCHES
#define MK_N_LAUNCHES 9
#endif

#define GAS __attribute__((address_space(1)))
#define LAS __attribute__((address_space(3)))
typedef unsigned short bf16;
typedef unsigned v4u __attribute__((ext_vector_type(4)));
typedef unsigned v2u __attribute__((ext_vector_type(2)));
typedef float f32x2 __attribute__((ext_vector_type(2)));
typedef float f32x4 __attribute__((ext_vector_type(4)));
typedef float f32x16 __attribute__((ext_vector_type(16)));
typedef short bf16x8 __attribute__((ext_vector_type(8)));
typedef __bf16 bf16v2 __attribute__((ext_vector_type(2)));
typedef GAS unsigned gu32;

constexpr int NB = 4, SEQ = 4096, D = 1024, T = NB * SEQ;
constexpr int LRU = 512, INW = 1536, NE = 32, DE2 = 2048, LISTCAP = 16384;
constexpr float EPS = 1e-6f;
constexpr int NWAVES = 8, NTHREADS = 512;
constexpr int N_PHASES = 9;
constexpr int N_LAUNCHES = MK_N_LAUNCHES;
static_assert(N_LAUNCHES == 1 || N_LAUNCHES == N_PHASES, "MK_N_LAUNCHES is 1 or 9");
constexpr float LOG2E = 1.4426950408889634f;

constexpr size_t MiB = 1u << 20;
constexpr size_t WS_CTL = 0, CTL_ZERO_BYTES = 65536;
constexpr size_t WS_MODP = 1 * MiB;
constexpr size_t WS_CT = 1 * MiB + 512 * 1024;
constexpr size_t WS_GT = 2 * MiB;
constexpr size_t WS_WIN = 4 * MiB;
constexpr size_t WS_WOUT = 8 * MiB;
constexpr size_t WS_SLOT = 10 * MiB;
constexpr size_t WS_GATE = 11 * MiB;
constexpr size_t WS_LIST = 12 * MiB;
constexpr size_t WS_H = 16 * MiB;
constexpr size_t WS_U = 48 * MiB;
constexpr size_t WS_MIXIN = 96 * MiB;
constexpr size_t WS_MIX = 128 * MiB;
constexpr size_t WS_H2 = 160 * MiB;
constexpr size_t WS_W1 = 192 * MiB;
constexpr size_t WS_W2 = 320 * MiB;
constexpr size_t WS_ACT = 384 * MiB;
constexpr size_t WS_Y = 528 * MiB;
constexpr size_t WS_END = 672 * MiB;
constexpr int CW_TMO = 0, CW_BAR = 4096, CW_CNT = 8192;

constexpr int RING_BYTES = 131072;
constexpr int AUX_OFF = 131072;
constexpr int LDSCTL_OFF = 143360;
constexpr int LDS_BYTES = 147456;

#define RLX_AGENT __ATOMIC_RELAXED, __HIP_MEMORY_SCOPE_AGENT
#define LDS_WAIT() asm volatile("s_waitcnt lgkmcnt(0)" ::: "memory")
#define VM_WAIT() asm volatile("s_waitcnt vmcnt(0)" ::: "memory")

__device__ __forceinline__ unsigned pk2(float lo, float hi) { bf16v2 v; v.x = (__bf16)lo; v.y = (__bf16)hi; return __builtin_bit_cast(unsigned, v); }
__device__ __forceinline__ float bf_lo(unsigned w) { return __uint_as_float(w << 16); }
__device__ __forceinline__ float bf_hi(unsigned w) { return __uint_as_float(w & 0xffff0000u); }
__device__ __forceinline__ float wave_sum(float v) {
#pragma unroll
    for (int o = 1; o < 64; o <<= 1) v += __shfl_xor(v, o);
    return v;
}
__device__ __forceinline__ float fast_sigmoid(float z) { return __builtin_amdgcn_rcpf(1.0f + __builtin_amdgcn_exp2f(-z * LOG2E)); }
__device__ __forceinline__ float gelu_tanh(float x) {
    const float u = 0.7978845608028654f * (x + 0.044715f * x * x * x);
    const float e = __builtin_amdgcn_exp2f(2.0f * LOG2E * u);
    return x - x * __builtin_amdgcn_rcpf(e + 1.0f);
}

#define XB_TMO      128
#define XB_XCNT(j)  (256  + 64 * (j))
#define XB_XSUB(j)  (1280 + 64 * (j))
#define XB_XGEN(j)  (2304 + 64 * (j))
#define XB_TOP      3328
#define XB_TOPGEN   3392
#define XCD_BAR_WORDS 3456
#define XB_SPIN_CAP (1u << 18)
__device__ __forceinline__ unsigned xb_ld(unsigned* p)              { return __hip_atomic_load(p, __ATOMIC_RELAXED, __HIP_MEMORY_SCOPE_AGENT); }
__device__ __forceinline__ unsigned xb_add(unsigned* p, unsigned v) { return __hip_atomic_fetch_add(p, v, __ATOMIC_RELAXED, __HIP_MEMORY_SCOPE_AGENT); }
__device__ __forceinline__ unsigned xb_xcc_id() { return (unsigned)__builtin_amdgcn_s_getreg((3 << 11) | 20) & 0xFu; }
#define XB_SPIN(cond, bar) do { unsigned _sp = 0; while (cond) { __builtin_amdgcn_s_sleep(1); \
    if ((++_sp & 255u) == 0u) { if (xb_ld(&(bar)[XB_TMO])) break; if (_sp > XB_SPIN_CAP) { atomicAdd(&(bar)[XB_TMO], 1u); break; } } } } while (0)
struct XcdBarrier { unsigned* bar; unsigned x; volatile LAS unsigned* st; };
__device__ __forceinline__ XcdBarrier xcd_barrier_post(unsigned* bar, volatile LAS unsigned* st) {
    XcdBarrier b; b.bar = bar; b.x = xb_xcc_id(); b.st = st;
    if (threadIdx.x == 0) (void)xb_add(&bar[XB_XCNT(b.x)], 1u);
    return b;
}
__device__ __forceinline__ void xcd_barrier_complete(unsigned* bar, unsigned x, unsigned& nloc, unsigned& nx) {
    const unsigned G = gridDim.x * gridDim.y * gridDim.z;
    unsigned sum, cnt, mine, sp = 0u;
    for (;;) {
        sum = 0u; cnt = 0u; mine = 0u;
#pragma unroll
        for (unsigned j = 0; j < 16; ++j) { const unsigned c = xb_ld(&bar[XB_XCNT(j)]); sum += c; cnt += (c > 0u) ? 1u : 0u; mine = (j == x) ? c : mine; }
        if (sum == G) break;
        __builtin_amdgcn_s_sleep(1);
        if ((++sp & 255u) == 0u) { if (xb_ld(&bar[XB_TMO])) break; if (sp > XB_SPIN_CAP) { atomicAdd(&bar[XB_TMO], 1u); break; } }
    }
    nloc = mine > 0u ? mine : 1u; nx = cnt > 0u ? cnt : 1u;
}
__device__ __forceinline__ void xcd_barrier(const XcdBarrier& b) {
    asm volatile("s_waitcnt vmcnt(0)" ::: "memory");
    __syncthreads();
    if (threadIdx.x == 0) {
        unsigned* bar = b.bar;
        __builtin_amdgcn_s_waitcnt(0);
        unsigned nloc = b.st[0], nx = b.st[1];
        if (nloc == 0u) { xcd_barrier_complete(bar, b.x, nloc, nx); b.st[0] = nloc; b.st[1] = nx; }
        const unsigned old = xb_add(&bar[XB_XSUB(b.x)], 1u);
        const unsigned gen = old / nloc;
        if (old + 1u == (gen + 1u) * nloc) {
            __builtin_amdgcn_fence(__ATOMIC_RELEASE, "agent");
            asm volatile("s_waitcnt vmcnt(0)" ::: "memory");
            const unsigned og = xb_add(&bar[XB_TOP], 1u);
            const unsigned tg = og / nx;
            if (og + 1u == (tg + 1u) * nx) xb_add(&bar[XB_TOPGEN], 1u);
            else XB_SPIN(xb_ld(&bar[XB_TOPGEN]) == tg, bar);
            __builtin_amdgcn_fence(__ATOMIC_ACQUIRE, "agent");
            xb_add(&bar[XB_XGEN(b.x)], 1u);
            asm volatile("s_waitcnt vmcnt(0)" ::: "memory");
        } else {
            XB_SPIN(xb_ld(&bar[XB_XGEN(b.x)]) == gen, bar);
            __builtin_amdgcn_fence(__ATOMIC_ACQUIRE, "agent");
            asm volatile("s_waitcnt vmcnt(0)" ::: "memory");
        }
    }
    __syncthreads();
}

namespace pg8 {
constexpr int BM = 256, BK = 64, HALF = 128, HTB = HALF * BK * 2, STAGE_BYTES = 8 * HTB, NXCD = 8, WGM = 8;
__device__ __forceinline__ int lds_byte(int r, int c) { const int st = (r >> 4) * 2 + (c >> 5), rr = r & 15, cc = c & 31, ob = rr * 64 + cc * 2; return st * 1024 + (ob ^ (((ob >> 9) & 1) << 5)); }
__device__ __forceinline__ void stage_rc(int b, int& R, int& C) { const int st = b / 1024, sb = b % 1024, swz = sb ^ (((sb >> 9) & 1) << 5); R = (st >> 1) * 16 + swz / 64; C = (st & 1) * 32 + (swz % 64) / 2; }
__device__ __forceinline__ int perm32(int rho) { const int n = rho >> 4, i = rho & 15; return 8 * (i >> 2) + 4 * n + (i & 3); }

struct Unit { int row0, col0, e, mt; };

struct StaticSched {
    const char* Bt; int K, nM, nN, nwg, G, c;
    __device__ __forceinline__ void init(const void* Bt_, int M, int N, int K_, int G_, int c_) { Bt = (const char*)Bt_; K = K_; nM = M / BM; nN = N / BM; nwg = nM * nN; G = G_; c = c_; }
    __device__ __forceinline__ bool next(int i, Unit& u) const {
        const long L = (long)i * G + c; if (L >= nwg) return false;
        int wgid = (int)L; { const int q = nwg / NXCD, r = nwg % NXCD, xcd = wgid % NXCD, off = wgid / NXCD; wgid = (xcd < r ? xcd * (q + 1) : r * (q + 1) + (xcd - r) * q) + off; }
        const int nig = WGM * nN, gid = wgid / nig, fm = gid * WGM, gsz = (nM - fm) < WGM ? (nM - fm) : WGM;
        u.row0 = BM * (fm + ((wgid % nig) % gsz)); u.col0 = BM * ((wgid % nig) / gsz); u.e = 0; u.mt = 0; return true;
    }
    __device__ __forceinline__ const char* b_base(const Unit& u) const { return Bt + (size_t)u.col0 * K * 2; }
    __device__ __forceinline__ void a_off(const Unit& u, const int (&R)[2], const int (&C)[2], unsigned (&off)[2][2]) const {
#pragma unroll
        for (int h = 0; h < 2; ++h)
#pragma unroll
            for (int i = 0; i < 2; ++i) off[h][i] = (unsigned)((u.row0 + HALF * h + R[i]) * K + C[i]) * 2u;
    }
};
template <bool GATHER> struct MoeSched {
    const char* Bt; size_t estride; LAS const int* tab; LAS const int* cnt; const int* list; int nunits;
    __device__ __forceinline__ bool next(int i, Unit& u) const {
        if (i >= nunits) return false;
        u.e = __builtin_amdgcn_readfirstlane(tab[4 * i + 0]); u.mt = __builtin_amdgcn_readfirstlane(tab[4 * i + 1]);
        u.row0 = BM * __builtin_amdgcn_readfirstlane(tab[4 * i + 2]); u.col0 = BM * __builtin_amdgcn_readfirstlane(tab[4 * i + 3]); return true;
    }
    __device__ __forceinline__ const char* b_base(const Unit& u) const { return Bt + (size_t)u.e * estride + (size_t)u.col0 * D * 2; }
    __device__ __forceinline__ void a_off(const Unit& u, const int (&R)[2], const int (&C)[2], unsigned (&off)[2][2]) const {
        if constexpr (GATHER) {
            const int n = cnt[u.e]; const int* lp = list + (size_t)u.e * LISTCAP;
#pragma unroll
            for (int h = 0; h < 2; ++h)
#pragma unroll
                for (int i = 0; i < 2; ++i) { int r = BM * u.mt + HALF * h + R[i]; r = r < n ? r : n - 1; const int tok = lp[r]; off[h][i] = (unsigned)(tok * D + C[i]) * 2u; }
        } else {
#pragma unroll
            for (int h = 0; h < 2; ++h)
#pragma unroll
                for (int i = 0; i < 2; ++i) off[h][i] = (unsigned)((u.row0 + HALF * h + R[i]) * D + C[i]) * 2u;
        }
    }
};

struct EpiBf16 {
    static constexpr bool PERM = true;
    bf16* O; int ldc; const float* bias; int bias_estride;
    __device__ __forceinline__ void operator()(const f32x4 (&acc)[2][2][4][2], const Unit& u, int wr, int wc, int fr, int fq) const {
        const int row0 = u.row0 + wr * 64 + fr, col0 = u.col0 + wc * 32 + 8 * fq;
        f32x4 bv[2][2];
#pragma unroll
        for (int bj = 0; bj < 2; ++bj)
#pragma unroll
            for (int n = 0; n < 2; ++n) bv[bj][n] = bias ? *(const f32x4*)(bias + (size_t)u.e * bias_estride + col0 + bj * HALF + 4 * n) : (f32x4){0.f, 0.f, 0.f, 0.f};
#pragma unroll
        for (int ai = 0; ai < 2; ++ai)
#pragma unroll
            for (int m = 0; m < 4; ++m) { bf16* rowp = O + (size_t)(row0 + ai * HALF + m * 16) * ldc + col0;
#pragma unroll
                for (int bj = 0; bj < 2; ++bj) { const f32x4 v0 = acc[ai][bj][m][0] + bv[bj][0], v1 = acc[ai][bj][m][1] + bv[bj][1];
                    v4u w; w.x = pk2(v0[0], v0[1]); w.y = pk2(v0[2], v0[3]); w.z = pk2(v1[0], v1[1]); w.w = pk2(v1[2], v1[3]);
                    *(v4u*)(rowp + bj * HALF) = w; } }
    }
};
struct EpiSwiglu {
    static constexpr bool PERM = false;
    bf16* O; const float* b1;
    __device__ __forceinline__ void operator()(const f32x4 (&acc)[2][2][4][2], const Unit& u, int wr, int wc, int fr, int fq) const {
        const int row0 = u.row0 + wr * 64 + fr;
        const int j0 = (u.col0 >> 1) + 16 * wc + 4 * fq;
        f32x4 bg[2], bl[2];
#pragma unroll
        for (int bj = 0; bj < 2; ++bj) { const float* bp = b1 + (size_t)u.e * DE2 + 2 * (j0 + 64 * bj); const f32x4 p = *(const f32x4*)bp, q = *(const f32x4*)(bp + 4);
            bg[bj] = (f32x4){p[0], p[2], q[0], q[2]}; bl[bj] = (f32x4){p[1], p[3], q[1], q[3]}; }
#pragma unroll
        for (int ai = 0; ai < 2; ++ai)
#pragma unroll
            for (int m = 0; m < 4; ++m) { bf16* rowp = O + (size_t)(row0 + ai * HALF + m * 16) * D + j0;
#pragma unroll
                for (int bj = 0; bj < 2; ++bj) { const f32x4 g = acc[ai][bj][m][0] + bg[bj], l = acc[ai][bj][m][1] + bl[bj]; float o[4];
#pragma unroll
                    for (int x = 0; x < 4; ++x) { const float gl = fminf(g[x], 7.0f), li = fminf(fmaxf(l[x], -7.0f), 7.0f);
                        o[x] = gl * __builtin_amdgcn_rcpf(1.0f + __builtin_amdgcn_exp2f(-1.702f * LOG2E * gl)) * (li + 1.0f); }
                    v2u w; w.x = pk2(o[0], o[1]); w.y = pk2(o[2], o[3]);
                    *(v2u*)(rowp + bj * 64) = w; } }
    }
};

template <class Epi, class Sched>
__device__ __forceinline__ void gemm_phase(LAS unsigned char* lds, const char* Abase, const int K, const Sched& S, const Epi& E) {
    const int tid = threadIdx.x, wid = __builtin_amdgcn_readfirstlane(tid >> 6), lane = tid & 63, wr = wid >> 2, wc = wid & 3, fr = lane & 15, fq = lane >> 4;
    const int nt = K / BK;
    int R[2], C[2]; unsigned voffB[2];
#pragma unroll
    for (int i = 0; i < 2; ++i) { stage_rc(tid * 16 + i * 8192, R[i], C[i]); const int Rb = Epi::PERM ? ((R[i] & ~31) + perm32(R[i] & 31)) : R[i]; voffB[i] = (unsigned)(Rb * K + C[i]) * 2u; }
    const size_t kstep = (size_t)(BK * 2);
    const size_t hstep = (size_t)HALF * K * 2;
    const unsigned ldsw = (unsigned)wid * 1024u;
    const int aoff = lds_byte(wr * 64 + fr, fq * 8), boff = lds_byte(wc * 32 + fr, fq * 8);
#define PG8_SA(b, h) (((b) * 2 + (h)) * HTB)
#define PG8_SB(b, h) ((4 + (b) * 2 + (h)) * HTB)
#define PG8_STAGEB(bufoff, gbase) do { _Pragma("unroll") for (int _i = 0; _i < 2; ++_i) \
        __builtin_amdgcn_global_load_lds((const unsigned*)((const char*)(gbase) + voffB[_i]), (LAS unsigned*)(lds + (bufoff) + ldsw + _i * 8192), 16, 0, 0); } while (0)
#define PG8_STAGEA(bufoff, o, h, kb) do { _Pragma("unroll") for (int _i = 0; _i < 2; ++_i) \
        __builtin_amdgcn_global_load_lds((const unsigned*)(Abase + (size_t)(o)[h][_i] + (size_t)(kb)), (LAS unsigned*)(lds + (bufoff) + ldsw + _i * 8192), 16, 0, 0); } while (0)
#define PG8_LDA(dst, b, h) do { _Pragma("unroll") for (int m = 0; m < 4; ++m) _Pragma("unroll") for (int k = 0; k < 2; ++k) dst[m][k] = *(const LAS bf16x8*)(lds + PG8_SA(b, h) + aoff + m * 2048 + k * 1024); } while (0)
#define PG8_LDB(dst, b, h) do { _Pragma("unroll") for (int n = 0; n < 2; ++n) _Pragma("unroll") for (int k = 0; k < 2; ++k) dst[n][k] = *(const LAS bf16x8*)(lds + PG8_SB(b, h) + boff + n * 2048 + k * 1024); } while (0)
#define PG8_MMA(ai, bj, At, Bt) do { __builtin_amdgcn_s_setprio(1); _Pragma("unroll") for (int m = 0; m < 4; ++m) _Pragma("unroll") for (int n = 0; n < 2; ++n) _Pragma("unroll") for (int k = 0; k < 2; ++k) \
        acc[ai][bj][m][n] = __builtin_amdgcn_mfma_f32_16x16x32_bf16(Bt[n][k], At[m][k], acc[ai][bj][m][n], 0, 0, 0); __builtin_amdgcn_s_setprio(0); } while (0)
#define PG8_WAIT_V(n) asm volatile("s_waitcnt vmcnt(" #n ")" ::: "memory")
#define PG8_WAIT_L(n) asm volatile("s_waitcnt lgkmcnt(" #n ")" ::: "memory")
#define PG8_BAR __builtin_amdgcn_s_barrier()
#define PG8_SCHED __builtin_amdgcn_sched_barrier(0)
    Unit cur, nxt; int ui = 0;
    if (!S.next(0, cur)) return;
    f32x4 acc[2][2][4][2];
#pragma unroll
    for (int a = 0; a < 2; ++a)
#pragma unroll
        for (int b = 0; b < 2; ++b)
#pragma unroll
            for (int m = 0; m < 4; ++m)
#pragma unroll
                for (int n = 0; n < 2; ++n) acc[a][b][m][n] = (f32x4){0.f, 0.f, 0.f, 0.f};
    bf16x8 At[4][2], B0[2][2], B1[2][2];
    unsigned offA[2][2], offN[2][2];
    S.a_off(cur, R, C, offA);
    const char* cB = S.b_base(cur);
    PG8_STAGEB(PG8_SB(0, 0), cB); PG8_STAGEB(PG8_SB(0, 1), cB + hstep); PG8_STAGEA(PG8_SA(0, 0), offA, 0, 0); PG8_STAGEA(PG8_SA(0, 1), offA, 1, 0);
    if (wr == 1) PG8_BAR;
    PG8_WAIT_V(2); PG8_BAR;
    PG8_STAGEB(PG8_SB(1, 0), cB + kstep); PG8_STAGEA(PG8_SA(1, 0), offA, 0, kstep); PG8_STAGEB(PG8_SB(1, 1), cB + hstep + kstep);
    PG8_WAIT_V(6); PG8_BAR;
    for (;;) {
        const bool has_next = S.next(ui + 1, nxt);
        const char* nB = has_next ? S.b_base(nxt) : cB;
        if (has_next) { S.a_off(nxt, R, C, offN); } else {
#pragma unroll
            for (int h = 0; h < 2; ++h)
#pragma unroll
                for (int i = 0; i < 2; ++i) offN[h][i] = offA[h][i]; }
        asm volatile("" : "+v"(offN[0][0]), "+v"(offN[0][1]), "+v"(offN[1][0]), "+v"(offN[1][1]));
        for (int t = 0; t < nt; t += 2) {
            const bool last = (t == nt - 2);
            const size_t k1 = (size_t)(t + 1) * kstep;
            const size_t k2 = last ? 0 : (size_t)(t + 2) * kstep, k3 = k2 + kstep;
            const char* b2 = last ? nB : cB + (size_t)(t + 2) * kstep; const char* b3 = b2 + kstep;
            unsigned o2[2][2];
#pragma unroll
            for (int h = 0; h < 2; ++h)
#pragma unroll
                for (int i = 0; i < 2; ++i) o2[h][i] = last ? offN[h][i] : offA[h][i];
            PG8_LDB(B0, 0, 0); PG8_LDB(B1, 0, 1); PG8_SCHED; PG8_LDA(At, 0, 0); PG8_STAGEA(PG8_SA(1, 1), offA, 1, k1);
            PG8_WAIT_V(8); PG8_WAIT_L(0); PG8_BAR; PG8_MMA(0, 0, At, B0); PG8_MMA(0, 1, At, B1); PG8_BAR; PG8_SCHED;
            PG8_LDA(At, 0, 1); PG8_STAGEB(PG8_SB(0, 0), b2); PG8_STAGEB(PG8_SB(0, 1), b2 + hstep); PG8_STAGEA(PG8_SA(0, 0), o2, 0, k2);
            PG8_WAIT_V(8); PG8_WAIT_L(0); PG8_BAR; PG8_MMA(1, 0, At, B0); PG8_MMA(1, 1, At, B1); PG8_BAR; PG8_SCHED;
            PG8_LDB(B0, 1, 0); PG8_LDB(B1, 1, 1); PG8_SCHED; PG8_LDA(At, 1, 0); PG8_STAGEA(PG8_SA(0, 1), o2, 1, k2);
            PG8_WAIT_V(8); PG8_WAIT_L(0); PG8_BAR; PG8_MMA(0, 0, At, B0); PG8_MMA(0, 1, At, B1); PG8_BAR; PG8_SCHED;
            PG8_LDA(At, 1, 1); PG8_STAGEB(PG8_SB(1, 0), b3); PG8_STAGEB(PG8_SB(1, 1), b3 + hstep); PG8_STAGEA(PG8_SA(1, 0), o2, 0, k3);
            PG8_WAIT_V(8); PG8_WAIT_L(0); PG8_BAR; PG8_MMA(1, 0, At, B0); PG8_MMA(1, 1, At, B1); PG8_BAR; PG8_SCHED;
        }
        if (wr == 0) PG8_BAR;
        E(acc, cur, wr, wc, fr, fq);
        if (!has_next) break;
#pragma unroll
        for (int a = 0; a < 2; ++a)
#pragma unroll
            for (int b = 0; b < 2; ++b)
#pragma unroll
                for (int m = 0; m < 4; ++m)
#pragma unroll
                    for (int n = 0; n < 2; ++n) acc[a][b][m][n] = (f32x4){0.f, 0.f, 0.f, 0.f};
        cur = nxt; cB = nB; ++ui;
#pragma unroll
        for (int h = 0; h < 2; ++h)
#pragma unroll
            for (int i = 0; i < 2; ++i) offA[h][i] = offN[h][i];
        if (wr == 1) PG8_BAR;
    }
    PG8_WAIT_V(0);
    PG8_BAR;
#undef PG8_SA
#undef PG8_SB
#undef PG8_STAGEA
#undef PG8_STAGEB
#undef PG8_LDA
#undef PG8_LDB
#undef PG8_MMA
#undef PG8_WAIT_V
#undef PG8_WAIT_L
#undef PG8_BAR
#undef PG8_SCHED
}
}

struct Frame {
    LAS unsigned char* lds;
    gu32* ctl;
    int tid, lane, wave, vcu, G;
    const float *x, *c, *w_ada, *b_ada, *g_mix_pre, *g_mix_post, *w_in, *conv_w, *conv_b, *gaw, *gab, *gxw, *gxb, *lam, *pool_w, *pool_b, *pool_s, *w_out,
                *g_ffn_pre, *g_ffn_post, *router_w, *router_b, *w1, *b1, *w2, *b2;
    float* out;
    float *modp, *CT, *gate; bf16 *GT, *WIN, *WOUT, *H, *U, *MIXIN, *MIX, *H2, *W1T, *W2T, *ACT, *Y; unsigned* slot; int* list;
};
__device__ __forceinline__ float modv(const Frame& F, int b, int n) {
    const float* p = F.modp + b * 6144 + n;
    return ((p[0] + p[4 * 6144]) + (p[8 * 6144] + p[12 * 6144])) + F.b_ada[n];
}

struct TrJob { const float* W; bf16* WT; int ldn, nblk, K, mode; };
__device__ __forceinline__ void tr_load(const TrJob& j, int item, int lane, f32x4 (&v)[8]) {
    const int kb = item / j.nblk, nb = item % j.nblk; const float* p = j.W + (size_t)(64 * kb + (lane >> 3)) * j.ldn + 32 * nb + 4 * (lane & 7);
#pragma unroll
    for (int i = 0; i < 8; ++i) v[i] = *(const f32x4*)(p + (size_t)(8 * i) * j.ldn);
}
__device__ __forceinline__ void tr_put(LAS float* scr, int lane, const f32x4 (&v)[8]) {
#pragma unroll
    for (int i = 0; i < 8; ++i) { LAS float* s = scr + (8 * i + (lane >> 3)) * 33 + 4 * (lane & 7); s[0] = v[i][0]; s[1] = v[i][1]; s[2] = v[i][2]; s[3] = v[i][3]; }
}
__device__ __forceinline__ void tr_store(const TrJob& j, int item, int lane, LAS const float* scr) {
    const int kb = item / j.nblk, nb = item % j.nblk, k0 = 64 * kb, n0 = 32 * nb, c = lane & 7;
#pragma unroll
    for (int q = 0; q < 4; ++q) { const int n = (lane >> 3) + 8 * q; LAS const float* s = scr + (8 * c) * 33 + n;
        v4u o; o.x = pk2(s[0 * 33], s[1 * 33]); o.y = pk2(s[2 * 33], s[3 * 33]); o.z = pk2(s[4 * 33], s[5 * 33]); o.w = pk2(s[6 * 33], s[7 * 33]);
        const int orow = j.mode ? n0 + ((n & 1) ? 16 + (n >> 1) : (n >> 1)) : n0 + n;
        *(v4u*)(j.WT + (size_t)orow * j.K + k0 + 8 * c) = o; }
}
__device__ __forceinline__ bool tr_job(const Frame& F, int it, TrJob& j, int& item) {
    constexpr int I_IN = 16 * 32, I_OUT = 16 * 32, I_W1 = 16 * 64, I_W2 = 16 * 32;
    if (it < I_IN) { j = TrJob{F.w_in, F.WIN, INW, 32, D, 0}; item = it; return true; } it -= I_IN;
    if (it < I_OUT) { j = TrJob{F.w_out, F.WOUT, D, 32, D, 0}; item = it; return true; } it -= I_OUT;
    if (it < NE * I_W1) { const int e = it / I_W1; j = TrJob{F.w1 + (size_t)e * D * DE2, F.W1T + (size_t)e * DE2 * D, DE2, 64, D, 1}; item = it % I_W1; return true; } it -= NE * I_W1;
    if (it < NE * I_W2) { const int e = it / I_W2; j = TrJob{F.w2 + (size_t)e * D * D, F.W2T + (size_t)e * D * D, D, 32, D, 0}; item = it % I_W2; return true; }
    return false;
}
__device__ __forceinline__ void p0_prologue(Frame& F) {
    const int tid = F.tid, lane = F.lane;
    for (int it = blockIdx.x; it < 256; it += F.G) {
        LAS float* cact = (LAS float*)F.lds; LAS float* red = (LAS float*)(F.lds + 4096);
        const int kq = it >> 6, nc = it & 63;
        for (int i = tid; i < 1024; i += NTHREADS) { const float cv = F.c[(i >> 8) * D + 256 * kq + (i & 255)]; cact[i] = cv / (1.0f + __expf(-cv)); }
        __syncthreads();
        if (tid < 504) {
            const int c4 = tid % 24, kl = tid / 24;
            f32x4 a0 = {0.f, 0.f, 0.f, 0.f}, a1 = a0, a2 = a0, a3 = a0;
            const float* wp = F.w_ada + (size_t)(256 * kq) * 6144 + 96 * nc + 4 * c4;
            for (int k = kl; k < 256; k += 21) { const f32x4 w = *(const f32x4*)(wp + (size_t)k * 6144);
                a0 += cact[k] * w; a1 += cact[256 + k] * w; a2 += cact[512 + k] * w; a3 += cact[768 + k] * w; }
            *(LAS f32x4*)(red + (kl * 4 + 0) * 96 + 4 * c4) = a0; *(LAS f32x4*)(red + (kl * 4 + 1) * 96 + 4 * c4) = a1;
            *(LAS f32x4*)(red + (kl * 4 + 2) * 96 + 4 * c4) = a2; *(LAS f32x4*)(red + (kl * 4 + 3) * 96 + 4 * c4) = a3;
        }
        __syncthreads();
        if (tid < 384) { const int b = tid / 96, col = tid % 96; float s = 0.f;
            for (int kl = 0; kl < 21; ++kl) s += red[(kl * 4 + b) * 96 + col];
            F.modp[(kq * 4 + b) * 6144 + 96 * nc + col] = s; }
        __syncthreads();
    }
    for (int it = blockIdx.x; it < 256; it += F.G) {
        LAS float* win = (LAS float*)F.lds;
        for (int i = tid; i < 2048; i += NTHREADS) win[i] = F.w_in[(size_t)(4 * it + (i >> 9)) * INW + 1024 + (i & 511)];
        __syncthreads();
        { const int g = tid >> 7, d = tid & 127; float a0 = 0.f, a1 = 0.f, a2 = 0.f, a3 = 0.f;
          const float* pw = F.pool_w + (size_t)g * 128 * 128 + d; LAS const float* wl = win + 128 * g;
          for (int cc = 0; cc < 128; ++cc) { const float p = pw[cc * 128]; a0 += wl[cc] * p; a1 += wl[512 + cc] * p; a2 += wl[1024 + cc] * p; a3 += wl[1536 + cc] * p; }
          v2u o; o.x = pk2(a0, a1); o.y = pk2(a2, a3);
          *(v2u*)(F.WIN + (size_t)(1024 + tid) * D + 4 * it) = o; }
        __syncthreads();
    }
    for (int gt = blockIdx.x * NTHREADS + tid; gt < 64 * 17 * 64; gt += F.G * NTHREADS) {
        const int l = gt & 63, s = (gt >> 6) % 17, un = gt / (64 * 17), h = un >> 3, o = un & 7, m = l & 31, kk0 = 8 * (l >> 5);
        float v[8];
#pragma unroll
        for (int jj = 0; jj < 8; ++jj) { const int kk = kk0 + jj; float val = 0.f;
            if (s < 16) { const int tap = s >> 2, i = 16 * (s & 3) + kk; const float cw = F.conv_w[tap * LRU + 64 * h + i];
                if (m < 8) val = cw * F.gaw[(size_t)(h * 64 + i) * 64 + 8 * o + m];
                else if (m < 16) val = cw * F.gxw[(size_t)(h * 64 + i) * 64 + 8 * o + m - 8];
                else if (m < 24) val = (i == 8 * o + m - 16) ? cw : 0.f;
            } else if (m >= 24) val = (kk == 8 * (o & 1) + m - 24) ? 1.0f : 0.f;
            v[jj] = val; }
        v4u w; w.x = pk2(v[0], v[1]); w.y = pk2(v[2], v[3]); w.z = pk2(v[4], v[5]); w.w = pk2(v[6], v[7]);
        *(v4u*)(F.GT + (size_t)gt * 8) = w;
    }
    for (int ch = blockIdx.x * NTHREADS + tid; ch < LRU; ch += F.G * NTHREADS) {
        const int h = ch >> 6, jn = ch & 63; float sa = 0.f, sx = 0.f;
        for (int i = 0; i < 64; ++i) { const float cb = F.conv_b[64 * h + i]; sa += cb * F.gaw[(size_t)(h * 64 + i) * 64 + jn]; sx += cb * F.gxw[(size_t)(h * 64 + i) * 64 + jn]; }
        const float lm = F.lam[ch]; const float sp = log1pf(__expf(-lm));
        f32x4 o; o[0] = sa + F.gab[ch]; o[1] = sx + F.gxb[ch]; o[2] = F.conv_b[ch]; o[3] = -8.0f * sp * LOG2E;
        *(f32x4*)(F.CT + 4 * ch) = o;
    }
    {
        LAS float* scr = (LAS float*)(F.lds + F.wave * 8448);
        const int gw = F.vcu * NWAVES + F.wave, NGW = F.G * NWAVES;
        constexpr int NITEMS = 512 + 512 + NE * 1024 + NE * 512;
        TrJob j, jn; int item = 0, itemn = 0; f32x4 v[8];
        int it = gw; bool have = it < NITEMS && tr_job(F, it, j, item);
        if (have) tr_load(j, item, lane, v);
        while (have) {
            tr_put(scr, lane, v);
            const int itn = it + NGW; const bool haven = itn < NITEMS && tr_job(F, itn, jn, itemn);
            if (haven) tr_load(jn, itemn, lane, v);
            LDS_WAIT(); asm volatile("" ::: "memory");
            tr_store(j, item, lane, scr);
            LDS_WAIT(); asm volatile("" ::: "memory");
            j = jn; item = itemn; it = itn; have = haven;
        }
    }
}

__device__ __forceinline__ void p1_prenorm(Frame& F) {
    LAS float* cH = (LAS float*)F.lds; LAS float* sh = cH + D;
    for (int rb = F.vcu; rb < T / 64; rb += F.G) {
        const int row0 = 64 * rb, b = row0 / SEQ;
        __syncthreads();
        for (int i = F.tid; i < D; i += NTHREADS) { cH[i] = F.g_mix_pre[i] * (1.0f + modv(F, b, D + i)); sh[i] = modv(F, b, i); }
        __syncthreads();
        for (int j = 0; j < 8; ++j) {
            const int row = row0 + 8 * F.wave + j; const f32x4* xr = (const f32x4*)(F.x + (size_t)row * D) + F.lane;
            f32x4 v[4]; float ss = 0.f;
#pragma unroll
            for (int q = 0; q < 4; ++q) { v[q] = xr[64 * q]; ss += (v[q][0] * v[q][0] + v[q][1] * v[q][1]) + (v[q][2] * v[q][2] + v[q][3] * v[q][3]); }
            const float rstd = rsqrtf(wave_sum(ss) * (1.0f / D) + EPS);
            v2u* o8 = (v2u*)(F.H + (size_t)row * D) + F.lane;
#pragma unroll
            for (int q = 0; q < 4; ++q) { const f32x4 cc = *(LAS const f32x4*)(cH + 4 * F.lane + 256 * q), ss4 = *(LAS const f32x4*)(sh + 4 * F.lane + 256 * q);
                const f32x4 hv = v[q] * rstd * cc + ss4; v2u w; w.x = pk2(hv[0], hv[1]); w.y = pk2(hv[2], hv[3]); o8[64 * q] = w; }
        }
    }
}

constexpr int XS_PITCH = 144, P3_AB = 74752, P3_YS = 123904;
__device__ __forceinline__ void p3_mixer(Frame& F) {
    const int tid = F.tid, lane = F.lane, w = F.wave, hh = lane >> 5, tl = lane & 31;
    LAS unsigned char* XS = F.lds;
    LAS float* ABa = (LAS float*)(F.lds + P3_AB); LAS float* ABb = ABa + 8 * 512; LAS float* ABg = ABb + 8 * 512;
    LAS bf16* YS = (LAS bf16*)(F.lds + P3_YS);
    for (int unit = F.vcu; unit < 256; unit += F.G) {
        const int b = unit >> 6, h = (unit >> 3) & 7, o = unit & 7;
        bf16x8 Af[17];
        { const bf16x8* gt = (const bf16x8*)F.GT + (size_t)((h * 8 + o) * 17) * 64 + lane;
#pragma unroll
          for (int s = 0; s < 17; ++s) Af[s] = gt[s * 64]; }
        float br[4], bi[4], bx[4], kc[4];
#pragma unroll
        for (int x = 0; x < 4; ++x) { const f32x4 c4 = *(const f32x4*)(F.CT + 4 * (64 * h + 8 * o + 4 * hh + x)); br[x] = c4[0]; bi[x] = c4[1]; bx[x] = c4[2]; kc[x] = c4[3]; }
        float carry = 0.f;
        const bf16* Ub = F.U + (size_t)(b * SEQ) * INW;
        __syncthreads();
        if (tid < 24) *(LAS v4u*)(XS + (tid >> 3) * XS_PITCH + (tid & 7) * 16) = (v4u){0u, 0u, 0u, 0u};
        v4u xr[8];
#pragma unroll
        for (int j = 0; j < 8; ++j) { const int p = tid + 512 * j; xr[j] = *(const v4u*)(Ub + (size_t)(p >> 3) * INW + 64 * h + 8 * (p & 7)); }
        for (int ck = 0; ck < 8; ++ck) {
            const int t0 = 512 * ck;
#pragma unroll
            for (int j = 0; j < 8; ++j) { const int p = tid + 512 * j; *(LAS v4u*)(XS + (3 + (p >> 3)) * XS_PITCH + (p & 7) * 16) = xr[j]; }
            bf16x8 gaf[2];
#pragma unroll
            for (int tile = 0; tile < 2; ++tile) gaf[tile] = *(const bf16x8*)(Ub + (size_t)(t0 + 64 * w + 32 * tile + tl) * INW + 512 + 64 * h + 16 * (o >> 1) + 8 * hh);
            __syncthreads();
            if (ck < 7) {
#pragma unroll
                for (int j = 0; j < 8; ++j) { const int p = tid + 512 * j; xr[j] = *(const v4u*)(Ub + (size_t)(t0 + 512 + (p >> 3)) * INW + 64 * h + 8 * (p & 7)); }
            }
#pragma unroll
            for (int tile = 0; tile < 2; ++tile) {
                const int tt = 64 * w + 32 * tile + tl;
                f32x16 acc;
#pragma unroll
                for (int i = 0; i < 16; ++i) acc[i] = 0.f;
#pragma unroll
                for (int s = 0; s < 16; ++s) { const int tap = s >> 2, q = s & 3;
                    const bf16x8 bf = *(LAS const bf16x8*)(XS + (tt + 3 - tap) * XS_PITCH + 32 * q + 16 * hh);
                    acc = __builtin_amdgcn_mfma_f32_32x32x16_bf16(Af[s], bf, acc, 0, 0, 0); }
                acc = __builtin_amdgcn_mfma_f32_32x32x16_bf16(Af[16], gaf[tile], acc, 0, 0, 0);
#pragma unroll
                for (int x = 0; x < 4; ++x) {
                    const float r = fast_sigmoid(acc[x] + br[x]), ig = fast_sigmoid(acc[4 + x] + bi[x]), xc = acc[8 + x] + bx[x];
                    const float a = __builtin_amdgcn_exp2f(r * kc[x]);
                    const float mult = __builtin_sqrtf(fmaxf(1.0f - a * a, 0.f));
                    const int idx = (4 * hh + x) * 512 + tt;
                    ABa[idx] = a; ABb[idx] = mult * ig * xc; ABg[idx] = gelu_tanh(acc[12 + x]);
                }
            }
            __syncthreads();
            if (tid < 24) *(LAS v4u*)(XS + (tid >> 3) * XS_PITCH + (tid & 7) * 16) = *(LAS const v4u*)(XS + (512 + (tid >> 3)) * XS_PITCH + (tid & 7) * 16);
            {
                const f32x4 a0 = *(LAS const f32x4*)(ABa + w * 512 + 8 * lane), a1 = *(LAS const f32x4*)(ABa + w * 512 + 8 * lane + 4);
                const f32x4 b0 = *(LAS const f32x4*)(ABb + w * 512 + 8 * lane), b1 = *(LAS const f32x4*)(ABb + w * 512 + 8 * lane + 4);
                const f32x4 g0 = *(LAS const f32x4*)(ABg + w * 512 + 8 * lane), g1 = *(LAS const f32x4*)(ABg + w * 512 + 8 * lane + 4);
                float av[8] = {a0[0], a0[1], a0[2], a0[3], a1[0], a1[1], a1[2], a1[3]}, bv[8] = {b0[0], b0[1], b0[2], b0[3], b1[0], b1[1], b1[2], b1[3]};
                float gv[8] = {g0[0], g0[1], g0[2], g0[3], g1[0], g1[1], g1[2], g1[3]};
                float hl[8], pc[8]; float hcur = 0.f, pcur = 1.f;
#pragma unroll
                for (int i = 0; i < 8; ++i) { hcur = av[i] * hcur + bv[i]; pcur *= av[i]; hl[i] = hcur; pc[i] = pcur; }
                float A = pcur, B = hcur;
#pragma unroll
                for (int d = 1; d < 64; d <<= 1) { const float Ap = __shfl_up(A, d), Bp = __shfl_up(B, d); if (lane >= d) { B = A * Bp + B; A = A * Ap; } }
                float Ae = __shfl_up(A, 1), Be = __shfl_up(B, 1); if (lane == 0) { Ae = 1.f; Be = 0.f; }
                const float hin = Ae * carry + Be;
                float hv[8];
#pragma unroll
                for (int i = 0; i < 8; ++i) hv[i] = hl[i] + pc[i] * hin;
                carry = __shfl(hv[7], 63);
#pragma unroll
                for (int i = 0; i < 8; ++i) YS[(8 * lane + i) * 8 + w] = (bf16)(pk2(hv[i] * gv[i], 0.f) & 0xffffu);
            }
            __syncthreads();
            *(v4u*)(F.MIXIN + (size_t)(b * SEQ + t0 + tid) * D + 64 * h + 8 * o) = *(LAS const v4u*)(YS + tid * 8);
        }
    }
    for (int it = F.vcu; it < 256; it += F.G) {
        const int idx = it * NTHREADS + tid, run = idx >> 6, cg = idx & 63, row0 = 8 * run, t = row0 & (SEQ - 1), wd = 2 << (cg >> 4);
        const bf16* vp = F.U + (size_t)row0 * INW + 1024 + 8 * cg;
        float s[8] = {0.f, 0.f, 0.f, 0.f, 0.f, 0.f, 0.f, 0.f};
        for (int d = wd - 1; d >= 1; --d) if (t - d >= 0) { const v4u q = *(const v4u*)(vp - (long)d * INW);
            s[0] += bf_lo(q.x); s[1] += bf_hi(q.x); s[2] += bf_lo(q.y); s[3] += bf_hi(q.y); s[4] += bf_lo(q.z); s[5] += bf_hi(q.z); s[6] += bf_lo(q.w); s[7] += bf_hi(q.w); }
        const f32x4 pb0 = *(const f32x4*)(F.pool_b + 8 * cg), pb1 = *(const f32x4*)(F.pool_b + 8 * cg + 4), ps0 = *(const f32x4*)(F.pool_s + 8 * cg), ps1 = *(const f32x4*)(F.pool_s + 8 * cg + 4);
        for (int i = 0; i < 8; ++i) {
            const v4u q = *(const v4u*)(vp + (size_t)i * INW);
            const float cv[8] = {bf_lo(q.x), bf_hi(q.x), bf_lo(q.y), bf_hi(q.y), bf_lo(q.z), bf_hi(q.z), bf_lo(q.w), bf_hi(q.w)};
            const int cnt = (t + i + 1) < wd ? (t + i + 1) : wd; const float rc = 1.0f / (float)cnt;
            float ov[8];
#pragma unroll
            for (int x = 0; x < 8; ++x) { s[x] += cv[x]; ov[x] = (s[x] * rc - cv[x] + (x < 4 ? pb0[x & 3] : pb1[x & 3])) * (x < 4 ? ps0[x & 3] : ps1[x & 3]); }
            v4u ow; ow.x = pk2(ov[0], ov[1]); ow.y = pk2(ov[2], ov[3]); ow.z = pk2(ov[4], ov[5]); ow.w = pk2(ov[6], ov[7]);
            *(v4u*)(F.MIXIN + (size_t)(row0 + i) * D + 512 + 8 * cg) = ow;
            const int tb = t + i - wd + 1;
            if (tb >= 0) { const v4u z = *(const v4u*)(vp + (long)(i - wd + 1) * INW);
                s[0] -= bf_lo(z.x); s[1] -= bf_hi(z.x); s[2] -= bf_lo(z.y); s[3] -= bf_hi(z.y); s[4] -= bf_lo(z.z); s[5] -= bf_hi(z.z); s[6] -= bf_lo(z.w); s[7] -= bf_hi(z.w); }
        }
    }
}

constexpr int P5_VEC = AUX_OFF;
constexpr int P5_MISC = LDSCTL_OFF + 64;
static_assert(P5_MISC + 2304 <= LDS_BYTES, "LDS map");
__device__ __forceinline__ void p5_rows(Frame& F) {
    const int tid = F.tid, lane = F.lane, w = F.wave;
    LAS float* RWT = (LAS float*)F.lds;
    LAS float* cA = (LAS float*)(F.lds + P5_VEC); LAS float* cB = cA + D; LAS float* shF = cB + D;
    LAS int* lcnt = (LAS int*)(F.lds + P5_MISC); LAS int* lbase = lcnt + 32; LAS int* rowe = lbase + 32; LAS int* rowr = rowe + 256;
    __syncthreads();
    for (int i = tid; i < D * 8; i += NTHREADS) { const int col = i >> 3, e4 = i & 7; const f32x4 v = *(const f32x4*)(F.router_w + (size_t)col * NE + 4 * e4);
        RWT[(4 * e4 + 0) * D + col] = v[0]; RWT[(4 * e4 + 1) * D + col] = v[1]; RWT[(4 * e4 + 2) * D + col] = v[2]; RWT[(4 * e4 + 3) * D + col] = v[3]; }
    for (int rb = F.vcu; rb < T / 64; rb += F.G) {
        const int row0 = 64 * rb, b = row0 / SEQ;
        __syncthreads();
        for (int i = tid; i < D; i += NTHREADS) { cA[i] = modv(F, b, 2 * D + i) * F.g_mix_post[i]; cB[i] = F.g_ffn_pre[i] * (1.0f + modv(F, b, 4 * D + i)); shF[i] = modv(F, b, 3 * D + i); }
        if (tid < 32) lcnt[tid] = 0;
        __syncthreads();
#pragma unroll 1
        for (int jr = 0; jr < 8; ++jr) {
            const int rl = 8 * w + jr, row = row0 + rl;
            float hA[16];
            {
                f32x4 xv[4], mv[4]; float ss = 0.f;
#pragma unroll
                for (int q = 0; q < 4; ++q) { xv[q] = *((const f32x4*)(F.x + (size_t)row * D) + lane + 64 * q); const v2u mw = *((const v2u*)(F.MIX + (size_t)row * D) + lane + 64 * q);
                    mv[q] = (f32x4){bf_lo(mw.x), bf_hi(mw.x), bf_lo(mw.y), bf_hi(mw.y)}; ss += (mv[q][0] * mv[q][0] + mv[q][1] * mv[q][1]) + (mv[q][2] * mv[q][2] + mv[q][3] * mv[q][3]); }
                const float rs = rsqrtf(wave_sum(ss) * (1.0f / D) + EPS); float s1 = 0.f;
#pragma unroll
                for (int q = 0; q < 4; ++q) { const f32x4 ca = *(LAS const f32x4*)(cA + 4 * lane + 256 * q); xv[q] = xv[q] + ca * (mv[q] * rs);
                    *((f32x4*)(F.out + (size_t)row * D) + lane + 64 * q) = xv[q]; s1 += (xv[q][0] * xv[q][0] + xv[q][1] * xv[q][1]) + (xv[q][2] * xv[q][2] + xv[q][3] * xv[q][3]); }
                const float r1 = rsqrtf(wave_sum(s1) * (1.0f / D) + EPS);
#pragma unroll
                for (int q = 0; q < 4; ++q) { const f32x4 cb = *(LAS const f32x4*)(cB + 4 * lane + 256 * q), sf = *(LAS const f32x4*)(shF + 4 * lane + 256 * q);
                    const f32x4 hv = xv[q] * r1 * cb + sf; v2u hw; hw.x = pk2(hv[0], hv[1]); hw.y = pk2(hv[2], hv[3]); *((v2u*)(F.H2 + (size_t)row * D) + lane + 64 * q) = hw;
                    hA[4 * q + 0] = hv[0]; hA[4 * q + 1] = hv[1]; hA[4 * q + 2] = hv[2]; hA[4 * q + 3] = hv[3]; }
            }
            asm volatile("" ::: "memory");
            float p[32];
#pragma unroll
            for (int e = 0; e < 32; ++e) { float s0 = 0.f;
#pragma unroll
                for (int q = 0; q < 4; ++q) { const f32x4 wv = *(LAS const f32x4*)(RWT + e * D + 4 * lane + 256 * q);
                    s0 += (hA[4 * q] * wv[0] + hA[4 * q + 1] * wv[1]) + (hA[4 * q + 2] * wv[2] + hA[4 * q + 3] * wv[3]); }
                p[e] = s0; if ((e & 3) == 3) asm volatile("" ::: "memory"); }
            {
#define P5_RED(n, msk) { const bool up = (lane & (msk)) != 0; _Pragma("unroll") for (int i = 0; i < (n); ++i) { const float keep = up ? p[i + (n)] : p[i], send = up ? p[i] : p[i + (n)]; p[i] = keep + __shfl_xor(send, (msk)); } }
                P5_RED(16, 32) P5_RED(8, 16) P5_RED(4, 8) P5_RED(2, 4) P5_RED(1, 2)
#undef P5_RED
                float val = p[0] + __shfl_xor(p[0], 1);
                const int me = lane >> 1; val += F.router_b[me];
                float tv[4]; int te[4];
#pragma unroll
                for (int k = 0; k < 4; ++k) { float m = val; int mi = me;
#pragma unroll
                    for (int d = 1; d < 64; d <<= 1) { const float om = __shfl_xor(m, d); const int oi = __shfl_xor(mi, d); if (om > m || (om == m && oi < mi)) { m = om; mi = oi; } }
                    tv[k] = m; te[k] = mi; if (me == mi) val = -3.0e38f; }
                const float e1 = __expf(tv[1] - tv[0]), e2 = __expf(tv[2] - tv[0]), e3 = __expf(tv[3] - tv[0]); const float inv = 1.0f / (1.0f + e1 + e2 + e3);
                if (lane == 0) {
                    const float gts[4] = {inv, e1 * inv, e2 * inv, e3 * inv};
#pragma unroll
                    for (int k = 0; k < 4; ++k) { const int lr = __hip_atomic_fetch_add(lcnt + te[k], 1, __ATOMIC_RELAXED, __HIP_MEMORY_SCOPE_WORKGROUP); rowe[4 * rl + k] = te[k]; rowr[4 * rl + k] = lr; F.gate[(size_t)row * 4 + k] = gts[k]; }
                }
            }
        }
        __syncthreads();
        if (tid < 32) { const int n = lcnt[tid]; lbase[tid] = n ? (int)__hip_atomic_fetch_add((unsigned*)(F.ctl + CW_CNT + 64 * tid), (unsigned)n, RLX_AGENT) : 0; }
        __syncthreads();
        if (tid < 256) { const int e = rowe[tid], rank = lbase[e] + rowr[tid], row = row0 + (tid >> 2);
            F.list[(size_t)e * LISTCAP + rank] = row; F.slot[(size_t)row * 4 + (tid & 3)] = ((unsigned)e << 16) | (unsigned)rank; }
    }
}

__device__ __forceinline__ int moe_setup(Frame& F, int NT) {
    LAS int* aux = (LAS int*)(F.lds + AUX_OFF);
    __syncthreads();
    if (F.tid < 32) aux[F.tid] = (int)__hip_atomic_load((unsigned*)(F.ctl + CW_CNT + 64 * F.tid), RLX_AGENT);
    __syncthreads();
    if (F.tid == 0) { int tp = 0; for (int e = 0; e < NE; ++e) { aux[32 + e] = tp; tp += (aux[e] + 255) >> 8; } aux[64] = tp; }
    __syncthreads();
    const int total = aux[64] * NT;
    if (F.tid < 64) { const long L = (long)F.tid * F.G + F.vcu; int e = -1, mt = 0, mg = 0, pn = 0;
        if (L < total) { mg = (int)(L / NT); pn = (int)(L % NT); e = 0; for (int q = 1; q < NE; ++q) if (aux[32 + q] <= mg) e = q; mt = mg - aux[32 + e]; }
        aux[128 + 4 * F.tid + 0] = e; aux[128 + 4 * F.tid + 1] = mt; aux[128 + 4 * F.tid + 2] = mg; aux[128 + 4 * F.tid + 3] = pn; }
    __syncthreads();
    int n = 0; for (int i = 0; i < 64; ++i) if (aux[128 + 4 * i] >= 0) n = i + 1;
    return __builtin_amdgcn_readfirstlane(n);
}

__device__ __forceinline__ void p8_final(Frame& F) {
    LAS float* cF = (LAS float*)F.lds; LAS int* aux = (LAS int*)(F.lds + AUX_OFF);
    __syncthreads();
    if (F.tid < 32) aux[F.tid] = (int)__hip_atomic_load((unsigned*)(F.ctl + CW_CNT + 64 * F.tid), RLX_AGENT);
    __syncthreads();
    if (F.tid == 0) { int tp = 0; for (int e = 0; e < NE; ++e) { aux[32 + e] = tp; tp += (aux[e] + 255) >> 8; } }
    for (int rb = F.vcu; rb < T / 64; rb += F.G) {
        const int row0 = 64 * rb, b = row0 / SEQ;
        __syncthreads();
        for (int i = F.tid; i < D; i += NTHREADS) cF[i] = modv(F, b, 5 * D + i) * F.g_ffn_post[i];
        __syncthreads();
        for (int j = 0; j < 8; ++j) {
            const int row = row0 + 8 * F.wave + j;
            const v4u sl = *(const v4u*)(F.slot + (size_t)row * 4); const f32x4 gt = *(const f32x4*)(F.gate + (size_t)row * 4);
            const unsigned sv[4] = {sl.x, sl.y, sl.z, sl.w};
            float f[16];
#pragma unroll
            for (int i = 0; i < 16; ++i) f[i] = 0.f;
#pragma unroll
            for (int k = 0; k < 4; ++k) { const int e = (int)(sv[k] >> 16), pos = 256 * aux[32 + e] + (int)(sv[k] & 0xffffu); const float gk = gt[k];
                const v4u* yr = (const v4u*)(F.Y + (size_t)pos * D) + F.lane;
#pragma unroll
                for (int q = 0; q < 2; ++q) { const v4u y = yr[64 * q];
                    f[8 * q + 0] += gk * bf_lo(y.x); f[8 * q + 1] += gk * bf_hi(y.x); f[8 * q + 2] += gk * bf_lo(y.y); f[8 * q + 3] += gk * bf_hi(y.y);
                    f[8 * q + 4] += gk * bf_lo(y.z); f[8 * q + 5] += gk * bf_hi(y.z); f[8 * q + 6] += gk * bf_lo(y.w); f[8 * q + 7] += gk * bf_hi(y.w); } }
            float ss = 0.f;
#pragma unroll
            for (int i = 0; i < 16; ++i) ss += f[i] * f[i];
            const float rs = rsqrtf(wave_sum(ss) * (1.0f / D) + EPS);
#pragma unroll
            for (int q = 0; q < 2; ++q)
#pragma unroll
                for (int hq = 0; hq < 2; ++hq) { const int col = 512 * q + 8 * F.lane + 4 * hq; f32x4* op = (f32x4*)(F.out + (size_t)row * D + col); const f32x4 x1 = *op, cf = *(LAS const f32x4*)(cF + col);
                    f32x4 fv = {f[8 * q + 4 * hq], f[8 * q + 4 * hq + 1], f[8 * q + 4 * hq + 2], f[8 * q + 4 * hq + 3]};
                    *op = x1 + cf * (fv * rs); }
        }
    }
}

struct Args { const float* in[26]; float* out; unsigned char* ws; int ph_lo, ph_hi; };
__global__ void __launch_bounds__(NTHREADS, 2) fwd_kernel(Args args) {
    extern __shared__ __attribute__((aligned(16))) unsigned char lds[];
    Frame F;
    F.lds = (LAS unsigned char*)lds;
    F.tid = threadIdx.x; F.lane = F.tid & 63; F.wave = __builtin_amdgcn_readfirstlane(F.tid >> 6);
    F.G = gridDim.x; { const int bx = blockIdx.x; F.vcu = (F.G % 8 == 0) ? (bx % 8) * (F.G / 8) + bx / 8 : bx; }
    unsigned char* ws = args.ws;
    F.ctl = (gu32*)(ws + WS_CTL);
    F.x = args.in[0]; F.c = args.in[1]; F.w_ada = args.in[2]; F.b_ada = args.in[3]; F.g_mix_pre = args.in[4]; F.g_mix_post = args.in[5]; F.w_in = args.in[6];
    F.conv_w = args.in[7]; F.conv_b = args.in[8]; F.gaw = args.in[9]; F.gab = args.in[10]; F.gxw = args.in[11]; F.gxb = args.in[12]; F.lam = args.in[13];
    F.pool_w = args.in[14]; F.pool_b = args.in[15]; F.pool_s = args.in[16]; F.w_out = args.in[17]; F.g_ffn_pre = args.in[18]; F.g_ffn_post = args.in[19];
    F.router_w = args.in[20]; F.router_b = args.in[21]; F.w1 = args.in[22]; F.b1 = args.in[23]; F.w2 = args.in[24]; F.b2 = args.in[25];
    F.out = args.out;
    F.modp = (float*)(ws + WS_MODP); F.CT = (float*)(ws + WS_CT); F.gate = (float*)(ws + WS_GATE); F.GT = (bf16*)(ws + WS_GT); F.WIN = (bf16*)(ws + WS_WIN); F.WOUT = (bf16*)(ws + WS_WOUT);
    F.H = (bf16*)(ws + WS_H); F.U = (bf16*)(ws + WS_U); F.MIXIN = (bf16*)(ws + WS_MIXIN); F.MIX = (bf16*)(ws + WS_MIX); F.H2 = (bf16*)(ws + WS_H2);
    F.W1T = (bf16*)(ws + WS_W1); F.W2T = (bf16*)(ws + WS_W2); F.ACT = (bf16*)(ws + WS_ACT); F.Y = (bf16*)(ws + WS_Y); F.slot = (unsigned*)(ws + WS_SLOT); F.list = (int*)(ws + WS_LIST);
    for (int u = F.tid; u < (LDS_BYTES - LDSCTL_OFF) / 4; u += NTHREADS) ((LAS unsigned*)(F.lds + LDSCTL_OFF))[u] = 0u;
    __syncthreads();
    XcdBarrier bar; bar.bar = (unsigned*)(F.ctl + CW_BAR); bar.x = 0; bar.st = nullptr;
    if (N_LAUNCHES == 1) bar = xcd_barrier_post((unsigned*)(F.ctl + CW_BAR), (volatile LAS unsigned*)(F.lds + LDSCTL_OFF));
    const int lo = args.ph_lo, hi = args.ph_hi;
#ifndef PH_MASK
#define PH_MASK 0x1ff
#endif
#define IN(k) (((PH_MASK >> (k)) & 1) && lo <= (k) && (k) < hi)
#define SEAM(k) do { if (IN(k) && IN((k) + 1)) xcd_barrier(bar); } while (0)

    if (IN(0)) { p0_prologue(F); SEAM(0); }
    if (IN(1)) { p1_prenorm(F); SEAM(1); }
    if (IN(2)) {
        pg8::StaticSched S; S.init(F.WIN, T, INW, D, F.G, (int)blockIdx.x);
        pg8::EpiBf16 E{F.U, INW, nullptr, 0};
        pg8::gemm_phase<pg8::EpiBf16, pg8::StaticSched>(F.lds, (const char*)F.H, D, S, E);
        SEAM(2);
    }
    if (IN(3)) { p3_mixer(F); SEAM(3); }
    if (IN(4)) {
        pg8::StaticSched S; S.init(F.WOUT, T, D, D, F.G, (int)blockIdx.x);
        pg8::EpiBf16 E{F.MIX, D, nullptr, 0};
        pg8::gemm_phase<pg8::EpiBf16, pg8::StaticSched>(F.lds, (const char*)F.MIXIN, D, S, E);
        SEAM(4);
    }
    if (IN(5)) { p5_rows(F); SEAM(5); }
    if (IN(6)) {
        const int nu = moe_setup(F, 8);
        LAS const int* aux = (LAS const int*)(F.lds + AUX_OFF);
        pg8::MoeSched<true> S{(const char*)F.W1T, (size_t)DE2 * D * 2, aux + 128, aux, F.list, nu};
        pg8::EpiSwiglu E{F.ACT, F.b1};
        pg8::gemm_phase<pg8::EpiSwiglu, pg8::MoeSched<true>>(F.lds, (const char*)F.H2, D, S, E);
        SEAM(6);
    }
    if (IN(7)) {
        const int nu = moe_setup(F, 4);
        LAS const int* aux = (LAS const int*)(F.lds + AUX_OFF);
        pg8::MoeSched<false> S{(const char*)F.W2T, (size_t)D * D * 2, aux + 128, aux, F.list, nu};
        pg8::EpiBf16 E{F.Y, D, F.b2, D};
        pg8::gemm_phase<pg8::EpiBf16, pg8::MoeSched<false>>(F.lds, (const char*)F.ACT, D, S, E);
        SEAM(7);
    }
    if (IN(8)) { p8_final(F); }
#undef IN
#undef SEAM
}

extern "C" void kernel_launch(void* const* d_in, const int* in_sizes, int n_in, void* d_out, int out_size, void* d_ws, size_t ws_size, hipStream_t stream) {
    static int grid = 0;
    if (grid == 0) {
        if (n_in != 26 || out_size != T * D || ws_size < WS_END) { fprintf(stderr, "kernel_launch: unexpected shapes (n_in %d, out %d, ws %zu); nothing launched\n", n_in, out_size, ws_size); grid = -1; return; }
        int dev = 0, cus = 0, per_cu = 0;
        if (hipGetDevice(&dev) != hipSuccess || hipDeviceGetAttribute(&cus, hipDeviceAttributeMultiprocessorCount, dev) != hipSuccess) { grid = -1; return; }
        if (hipFuncSetAttribute((const void*)fwd_kernel, hipFuncAttributeMaxDynamicSharedMemorySize, LDS_BYTES) != hipSuccess) { fprintf(stderr, "kernel_launch: hipFuncSetAttribute failed\n"); grid = -1; return; }
        if (hipOccupancyMaxActiveBlocksPerMultiprocessor(&per_cu, (const void*)fwd_kernel, NTHREADS, LDS_BYTES) != hipSuccess || per_cu < 1) { fprintf(stderr, "kernel_launch: occupancy query says %d blocks per CU\n", per_cu); (void)hipGetLastError(); grid = -1; return; }
        grid = cus;
        if (grid > 256) grid = 256;
    }
    if (grid < 0) return;
    (void)hipMemsetAsync((char*)d_ws + WS_CTL, 0, CTL_ZERO_BYTES, stream);
    Args a{};
    for (int i = 0; i < 26; ++i) a.in[i] = (const float*)d_in[i];
    a.out = (float*)d_out; a.ws = (unsigned char*)d_ws;
    for (int li = 0; li < N_LAUNCHES; ++li) {
        a.ph_lo = (N_LAUNCHES == 1) ? 0 : li; a.ph_hi = (N_LAUNCHES == 1) ? N_PHASES : li + 1;
        hipLaunchKernelGGL(fwd_kernel, dim3(grid), dim3(NTHREADS), LDS_BYTES, stream, a);
    }
}
```

```cpp
#include <hip/hip_runtime.h>
#include <cstdio>
#include <cstdint>

#ifndef MK_N_LAUNCHES
#define MK_N_LAUNCHES 1
#endif

#define GAS __attribute__((address_space(1)))
#define LAS __attribute__((address_space(3)))
typedef unsigned short bf16;
typedef unsigned v4u __attribute__((ext_vector_type(4)));
typedef unsigned v2u __attribute__((ext_vector_type(2)));
typedef float f32x2 __attribute__((ext_vector_type(2)));
typedef float f32x4 __attribute__((ext_vector_type(4)));
typedef float f32x16 __attribute__((ext_vector_type(16)));
typedef short bf16x8 __attribute__((ext_vector_type(8)));
typedef __bf16 bf16v2 __attribute__((ext_vector_type(2)));
typedef int v4i __attribute__((ext_vector_type(4)));
typedef int v8i __attribute__((ext_vector_type(8)));
typedef GAS unsigned gu32;

constexpr int NB = 4, SEQ = 4096, D = 1024, T = NB * SEQ;
constexpr int LRU = 512, INW = 1536, NE = 32, DE2 = 2048, LISTCAP = 16384;
constexpr float EPS = 1e-6f;
constexpr int NWAVES = 8, NTHREADS = 512;
constexpr int N_PHASES = 9;
constexpr int NSTRIPS_ALL = 3072, NS_TAIL_PER = 4, NS_P0 = NSTRIPS_ALL - 128 * NS_TAIL_PER;
constexpr int N_LAUNCHES = MK_N_LAUNCHES;
static_assert(N_LAUNCHES == 1 || N_LAUNCHES == N_PHASES, "MK_N_LAUNCHES is 1 or 9");
constexpr float LOG2E = 1.4426950408889634f;

constexpr size_t MiB = 1u << 20;
constexpr size_t WS_CTL = 0, CTL_ZERO_BYTES = 65536;
constexpr size_t WS_MODP = 1 * MiB;
constexpr size_t WS_CT = 1 * MiB + 512 * 1024;
constexpr size_t WS_GT = 2 * MiB;
constexpr size_t WS_SW1 = 3 * MiB + 256 * 1024;
constexpr size_t WS_SW2 = 3 * MiB + 512 * 1024;
constexpr size_t WS_SCL = 14 * MiB;
constexpr size_t WS_WIN = 4 * MiB;
constexpr size_t WS_WOUT = 8 * MiB;
constexpr size_t WS_SLOT = 10 * MiB;
constexpr size_t WS_GATE = 11 * MiB;
constexpr size_t WS_LIST = 12 * MiB;
constexpr size_t WS_H = 16 * MiB;
constexpr size_t WS_U = 48 * MiB;
constexpr size_t WS_MIXIN = 96 * MiB;
constexpr size_t WS_MIX = 128 * MiB;
constexpr size_t WS_X1 = WS_MIXIN;
constexpr size_t WS_H2 = 160 * MiB;
constexpr size_t WS_W1 = 192 * MiB;
constexpr size_t WS_W2 = 320 * MiB;
constexpr size_t WS_ACT = 384 * MiB;
constexpr size_t WS_Y = 528 * MiB;
constexpr size_t WS_END = 672 * MiB;
constexpr int CW_TMO = 0, CW_BAR = 4096, CW_CNT = 8192;

constexpr int RING_BYTES = 131072;
constexpr int AUX_OFF = 131072;
constexpr int LDSCTL_OFF = 143360;
constexpr int LDS_BYTES = 147456;

#define RLX_AGENT __ATOMIC_RELAXED, __HIP_MEMORY_SCOPE_AGENT
#define LDS_WAIT() asm volatile("s_waitcnt lgkmcnt(0)" ::: "memory")
#define VM_WAIT() asm volatile("s_waitcnt vmcnt(0)" ::: "memory")

__device__ __forceinline__ unsigned pk2(float lo, float hi) { bf16v2 v; v.x = (__bf16)lo; v.y = (__bf16)hi; return __builtin_bit_cast(unsigned, v); }
__device__ __forceinline__ unsigned pk4_fp8(float a, float b, float c, float d) {
    a = __builtin_amdgcn_fmed3f(a, -448.0f, 448.0f); b = __builtin_amdgcn_fmed3f(b, -448.0f, 448.0f); c = __builtin_amdgcn_fmed3f(c, -448.0f, 448.0f); d = __builtin_amdgcn_fmed3f(d, -448.0f, 448.0f);
    int w = 0; w = __builtin_amdgcn_cvt_pk_fp8_f32(a, b, w, false); w = __builtin_amdgcn_cvt_pk_fp8_f32(c, d, w, true); return (unsigned)w; }
__device__ __forceinline__ unsigned pk4_fp8_nosat(float a, float b, float c, float d) { int w = 0; w = __builtin_amdgcn_cvt_pk_fp8_f32(a, b, w, false); w = __builtin_amdgcn_cvt_pk_fp8_f32(c, d, w, true); return (unsigned)w; }
__device__ __forceinline__ float bf_lo(unsigned w) { return __uint_as_float(w << 16); }
__device__ __forceinline__ float bf_hi(unsigned w) { return __uint_as_float(w & 0xffff0000u); }
__device__ __forceinline__ float wave_sum(float v) {
#pragma unroll
    for (int o = 1; o < 64; o <<= 1) v += __shfl_xor(v, o);
    return v;
}
__device__ __forceinline__ float fast_sigmoid(float z) { return __builtin_amdgcn_rcpf(1.0f + __builtin_amdgcn_exp2f(-z * LOG2E)); }
__device__ __forceinline__ float gelu_tanh(float x) {
    const float u = 0.7978845608028654f * (x + 0.044715f * x * x * x);
    const float e = __builtin_amdgcn_exp2f(2.0f * LOG2E * u);
    return x - x * __builtin_amdgcn_rcpf(e + 1.0f);
}

#define XB_TMO      128
#define XB_XCNT(j)  (256  + 64 * (j))
#define XB_XSUB(j)  (1280 + 64 * (j))
#define XB_XGEN(j)  (2304 + 64 * (j))
#define XB_TOP      3328
#define XB_TOPGEN   3392
#define XCD_BAR_WORDS 3456
#define XB_SPIN_CAP (1u << 18)
__device__ __forceinline__ unsigned xb_ld(unsigned* p)              { return __hip_atomic_load(p, __ATOMIC_RELAXED, __HIP_MEMORY_SCOPE_AGENT); }
__device__ __forceinline__ unsigned xb_add(unsigned* p, unsigned v) { return __hip_atomic_fetch_add(p, v, __ATOMIC_RELAXED, __HIP_MEMORY_SCOPE_AGENT); }
__device__ __forceinline__ unsigned xb_xcc_id() { return (unsigned)__builtin_amdgcn_s_getreg((3 << 11) | 20) & 0xFu; }
#define XB_SPIN(cond, bar) do { unsigned _sp = 0; while (cond) { __builtin_amdgcn_s_sleep(1); \
    if ((++_sp & 255u) == 0u) { if (xb_ld(&(bar)[XB_TMO])) break; if (_sp > XB_SPIN_CAP) { atomicAdd(&(bar)[XB_TMO], 1u); break; } } } } while (0)
struct XcdBarrier { unsigned* bar; unsigned x; volatile LAS unsigned* st; };
__device__ __forceinline__ XcdBarrier xcd_barrier_post(unsigned* bar, volatile LAS unsigned* st) {
    XcdBarrier b; b.bar = bar; b.x = xb_xcc_id(); b.st = st;
    if (threadIdx.x == 0) (void)xb_add(&bar[XB_XCNT(b.x)], 1u);
    return b;
}
__device__ __forceinline__ void xcd_barrier_complete(unsigned* bar, unsigned x, unsigned& nloc, unsigned& nx) {
    const unsigned G = gridDim.x * gridDim.y * gridDim.z;
    unsigned sum, cnt, mine, sp = 0u;
    for (;;) {
        sum = 0u; cnt = 0u; mine = 0u;
#pragma unroll
        for (unsigned j = 0; j < 16; ++j) { const unsigned c = xb_ld(&bar[XB_XCNT(j)]); sum += c; cnt += (c > 0u) ? 1u : 0u; mine = (j == x) ? c : mine; }
        if (sum == G) break;
        __builtin_amdgcn_s_sleep(1);
        if ((++sp & 255u) == 0u) { if (xb_ld(&bar[XB_TMO])) break; if (sp > XB_SPIN_CAP) { atomicAdd(&bar[XB_TMO], 1u); break; } }
    }
    nloc = mine > 0u ? mine : 1u; nx = cnt > 0u ? cnt : 1u;
}
__device__ __forceinline__ void xcd_barrier(const XcdBarrier& b) {
    asm volatile("s_waitcnt vmcnt(0)" ::: "memory");
    __syncthreads();
    if (threadIdx.x == 0) {
        unsigned* bar = b.bar;
        __builtin_amdgcn_s_waitcnt(0);
        unsigned nloc = b.st[0], nx = b.st[1];
        if (nloc == 0u) { xcd_barrier_complete(bar, b.x, nloc, nx); b.st[0] = nloc; b.st[1] = nx; }
        const unsigned old = xb_add(&bar[XB_XSUB(b.x)], 1u);
        const unsigned gen = old / nloc;
        if (old + 1u == (gen + 1u) * nloc) {
            __builtin_amdgcn_fence(__ATOMIC_RELEASE, "agent");
            asm volatile("s_waitcnt vmcnt(0)" ::: "memory");
            const unsigned og = xb_add(&bar[XB_TOP], 1u);
            const unsigned tg = og / nx;
            if (og + 1u == (tg + 1u) * nx) xb_add(&bar[XB_TOPGEN], 1u);
            else XB_SPIN(xb_ld(&bar[XB_TOPGEN]) == tg, bar);
            __builtin_amdgcn_fence(__ATOMIC_ACQUIRE, "agent");
            xb_add(&bar[XB_XGEN(b.x)], 1u);
            asm volatile("s_waitcnt vmcnt(0)" ::: "memory");
        } else {
            XB_SPIN(xb_ld(&bar[XB_XGEN(b.x)]) == gen, bar);
            __builtin_amdgcn_fence(__ATOMIC_ACQUIRE, "agent");
            asm volatile("s_waitcnt vmcnt(0)" ::: "memory");
        }
    }
    __syncthreads();
}

namespace pg8 {
constexpr int BM = 256, BK = 64, HALF = 128, HTB = HALF * BK * 2, STAGE_BYTES = 8 * HTB, NXCD = 8, WGM = 8;
__device__ __forceinline__ int lds_byte(int r, int c) { const int st = (r >> 4) * 2 + (c >> 5), rr = r & 15, cc = c & 31, ob = rr * 64 + cc * 2; return st * 1024 + (ob ^ (((ob >> 9) & 1) << 5)); }
__device__ __forceinline__ void stage_rc(int b, int& R, int& C) { const int st = b / 1024, sb = b % 1024, swz = sb ^ (((sb >> 9) & 1) << 5); R = (st >> 1) * 16 + swz / 64; C = (st & 1) * 32 + (swz % 64) / 2; }
__device__ __forceinline__ int perm32(int rho) { const int n = rho >> 4, i = rho & 15; return 8 * (i >> 2) + 4 * n + (i & 3); }

struct Unit { int row0, col0, e, mt; };

struct StaticSched {
    const char* Bt; int K, nM, nN, nwg, G, c;
    __device__ __forceinline__ void init(const void* Bt_, int M, int N, int K_, int G_, int c_) { Bt = (const char*)Bt_; K = K_; nM = M / BM; nN = N / BM; nwg = nM * nN; G = G_; c = c_; }
    __device__ __forceinline__ bool next(int i, Unit& u) const {
        const long L = (long)i * G + c; if (L >= nwg) return false;
        int wgid = (int)L; { const int q = nwg / NXCD, r = nwg % NXCD, xcd = wgid % NXCD, off = wgid / NXCD; wgid = (xcd < r ? xcd * (q + 1) : r * (q + 1) + (xcd - r) * q) + off; }
        const int nig = WGM * nN, gid = wgid / nig, fm = gid * WGM, gsz = (nM - fm) < WGM ? (nM - fm) : WGM;
        u.row0 = BM * (fm + ((wgid % nig) % gsz)); u.col0 = BM * ((wgid % nig) / gsz); u.e = 0; u.mt = 0; return true;
    }
    __device__ __forceinline__ const char* b_base(const Unit& u) const { return Bt + (size_t)u.col0 * K * 2; }
    __device__ __forceinline__ void a_off(const Unit& u, const int (&R)[2], const int (&C)[2], unsigned (&off)[2][2]) const {
#pragma unroll
        for (int h = 0; h < 2; ++h)
#pragma unroll
            for (int i = 0; i < 2; ++i) off[h][i] = (unsigned)((u.row0 + HALF * h + R[i]) * K + C[i]) * 2u;
    }
};
template <bool GATHER> struct MoeSched {
    const char* Bt; size_t estride; LAS const int* tab; LAS const int* cnt; const int* list; int nunits;
    __device__ __forceinline__ bool next(int i, Unit& u) const {
        if (i >= nunits) return false;
        u.e = __builtin_amdgcn_readfirstlane(tab[4 * i + 0]); u.mt = __builtin_amdgcn_readfirstlane(tab[4 * i + 1]);
        u.row0 = BM * __builtin_amdgcn_readfirstlane(tab[4 * i + 2]); u.col0 = BM * __builtin_amdgcn_readfirstlane(tab[4 * i + 3]); return true;
    }
    __device__ __forceinline__ const char* b_base(const Unit& u) const { return Bt + (size_t)u.e * estride + (size_t)u.col0 * 1024; }
    __device__ __forceinline__ void a_off(const Unit& u, const int (&R)[2], const int (&C)[2], unsigned (&off)[2][2]) const {
        if constexpr (GATHER) {
            const int n = cnt[u.e]; const int* lp = list + (size_t)u.e * LISTCAP;
#pragma unroll
            for (int h = 0; h < 2; ++h)
#pragma unroll
                for (int i = 0; i < 2; ++i) { int r = BM * u.mt + HALF * h + R[i]; r = r < n ? r : n - 1; const int tok = lp[r]; off[h][i] = (unsigned)(tok * 512 + C[i]) * 2u; }
        } else {
#pragma unroll
            for (int h = 0; h < 2; ++h)
#pragma unroll
                for (int i = 0; i < 2; ++i) off[h][i] = (unsigned)((u.row0 + HALF * h + R[i]) * 512 + C[i]) * 2u;
        }
    }
};

struct EpiBf16 {
    static constexpr bool PERM = true, F8 = false;
    bf16* O; int ldc; const float* bias; int bias_estride;
    __device__ __forceinline__ void operator()(const f32x4 (&acc)[2][2][4][2], const Unit& u, int wr, int wc, int fr, int fq) const {
        const int row0 = u.row0 + wr * 64 + fr, col0 = u.col0 + wc * 32 + 8 * fq;
        f32x4 bv[2][2];
#pragma unroll
        for (int bj = 0; bj < 2; ++bj)
#pragma unroll
            for (int n = 0; n < 2; ++n) bv[bj][n] = bias ? *(const f32x4*)(bias + (size_t)u.e * bias_estride + col0 + bj * HALF + 4 * n) : (f32x4){0.f, 0.f, 0.f, 0.f};
#pragma unroll
        for (int ai = 0; ai < 2; ++ai)
#pragma unroll
            for (int m = 0; m < 4; ++m) { bf16* rowp = O + (size_t)(row0 + ai * HALF + m * 16) * ldc + col0;
#pragma unroll
                for (int bj = 0; bj < 2; ++bj) { const f32x4 v0 = acc[ai][bj][m][0] + bv[bj][0], v1 = acc[ai][bj][m][1] + bv[bj][1];
                    v4u w; w.x = pk2(v0[0], v0[1]); w.y = pk2(v0[2], v0[3]); w.z = pk2(v1[0], v1[1]); w.w = pk2(v1[2], v1[3]);
                    *(v4u*)(rowp + bj * HALF) = w; } }
    }
};
struct EpiSwiglu8 {
    static constexpr bool PERM = false, F8 = true;
    unsigned char* O; const float* b1; const float* sW; const float* scl; LAS const int* cnt;
    __device__ __forceinline__ void operator()(const f32x4 (&acc)[2][2][4][2], const Unit& u, int wr, int wc, int fr, int fq) const {
        const int row0 = u.row0 + wr * 64 + fr, rank0 = BM * u.mt + wr * 64 + fr, n = cnt[u.e];
        const int j0 = (u.col0 >> 1) + 16 * wc + 4 * fq;
        f32x4 bg[2], bl[2], sg[2], sl[2];
#pragma unroll
        for (int bj = 0; bj < 2; ++bj) { const float* bp = b1 + (size_t)u.e * DE2 + 2 * (j0 + 64 * bj); const f32x4 p = *(const f32x4*)bp, q = *(const f32x4*)(bp + 4);
            bg[bj] = (f32x4){p[0], p[2], q[0], q[2]}; bl[bj] = (f32x4){p[1], p[3], q[1], q[3]};
            const float* sp = sW + (size_t)u.e * DE2 + u.col0 + 128 * bj + 32 * wc + 4 * fq; sg[bj] = *(const f32x4*)sp; sl[bj] = *(const f32x4*)(sp + 16); }
#pragma unroll
        for (int ai = 0; ai < 2; ++ai)
#pragma unroll
            for (int m = 0; m < 4; ++m) { const int rk = rank0 + ai * HALF + m * 16; const float sa = rk < n ? scl[(size_t)u.e * LISTCAP + rk] : 0.f;
                unsigned char* rowp = O + (size_t)(row0 + ai * HALF + m * 16) * 1024 + j0;
#pragma unroll
                for (int bj = 0; bj < 2; ++bj) { const f32x4 g = acc[ai][bj][m][0] * (sa * sg[bj]) + bg[bj], l = acc[ai][bj][m][1] * (sa * sl[bj]) + bl[bj]; float o[4];
#pragma unroll
                    for (int x = 0; x < 4; ++x) { const float gl = fminf(g[x], 7.0f), li8 = __builtin_amdgcn_fmed3f(l[x], -7.0f, 7.0f) * 8.0f + 8.0f;
                        o[x] = gl * __builtin_amdgcn_rcpf(1.0f + __builtin_amdgcn_exp2f(-1.702f * LOG2E * gl)) * li8; }
                    *(unsigned*)(rowp + bj * 64) = pk4_fp8_nosat(o[0], o[1], o[2], o[3]); } }
    }
};
struct EpiY8 {
    static constexpr bool PERM = true, F8 = true;
    bf16* O; const float* bias; const float* sW;
    __device__ __forceinline__ void operator()(const f32x4 (&acc)[2][2][4][2], const Unit& u, int wr, int wc, int fr, int fq) const {
        const int row0 = u.row0 + wr * 64 + fr, col0 = u.col0 + wc * 32 + 8 * fq;
        f32x4 bv[2][2], sv[2][2];
#pragma unroll
        for (int bj = 0; bj < 2; ++bj)
#pragma unroll
            for (int n = 0; n < 2; ++n) { bv[bj][n] = *(const f32x4*)(bias + (size_t)u.e * D + col0 + bj * HALF + 4 * n); sv[bj][n] = *(const f32x4*)(sW + (size_t)u.e * D + col0 + bj * HALF + 4 * n) * 0.125f; }
#pragma unroll
        for (int ai = 0; ai < 2; ++ai)
#pragma unroll
            for (int m = 0; m < 4; ++m) { bf16* rowp = O + (size_t)(row0 + ai * HALF + m * 16) * D + col0;
#pragma unroll
                for (int bj = 0; bj < 2; ++bj) { const f32x4 v0 = acc[ai][bj][m][0] * sv[bj][0] + bv[bj][0], v1 = acc[ai][bj][m][1] * sv[bj][1] + bv[bj][1];
                    v4u w; w.x = pk2(v0[0], v0[1]); w.y = pk2(v0[2], v0[3]); w.z = pk2(v1[0], v1[1]); w.w = pk2(v1[2], v1[3]);
                    *(v4u*)(rowp + bj * HALF) = w; } }
    }
};

template <class Epi, class Sched>
__device__ __forceinline__ void gemm_phase(LAS unsigned char* lds, const char* Abase, const int K, const Sched& S, const Epi& E) {
    const int tid = threadIdx.x, wid = __builtin_amdgcn_readfirstlane(tid >> 6), lane = tid & 63, wr = wid >> 2, wc = wid & 3, fr = lane & 15, fq = lane >> 4;
    const int nt = K / BK;
    int R[2], C[2]; unsigned voffB[2];
#pragma unroll
    for (int i = 0; i < 2; ++i) { stage_rc(tid * 16 + i * 8192, R[i], C[i]); const int Rb = Epi::PERM ? ((R[i] & ~31) + perm32(R[i] & 31)) : R[i]; voffB[i] = (unsigned)(Rb * K + C[i]) * 2u; }
    const size_t kstep = (size_t)(BK * 2);
    const size_t hstep = (size_t)HALF * K * 2;
    const unsigned ldsw = (unsigned)wid * 1024u;
    const int aoff = lds_byte(wr * 64 + fr, fq * 8), boff = lds_byte(wc * 32 + fr, fq * 8);
#define PG8_SA(b, h) (((b) * 2 + (h)) * HTB)
#define PG8_SB(b, h) ((4 + (b) * 2 + (h)) * HTB)
#define PG8_STAGEB(bufoff, gbase) do { _Pragma("unroll") for (int _i = 0; _i < 2; ++_i) \
        __builtin_amdgcn_global_load_lds((const unsigned*)((const char*)(gbase) + voffB[_i]), (LAS unsigned*)(lds + (bufoff) + ldsw + _i * 8192), 16, 0, 0); } while (0)
#define PG8_STAGEA(bufoff, o, h, kb) do { _Pragma("unroll") for (int _i = 0; _i < 2; ++_i) \
        __builtin_amdgcn_global_load_lds((const unsigned*)(Abase + (size_t)(o)[h][_i] + (size_t)(kb)), (LAS unsigned*)(lds + (bufoff) + ldsw + _i * 8192), 16, 0, 0); } while (0)
#define PG8_LDA(dst, b, h) do { _Pragma("unroll") for (int m = 0; m < 4; ++m) _Pragma("unroll") for (int k = 0; k < 2; ++k) dst[m][k] = *(const LAS bf16x8*)(lds + PG8_SA(b, h) + aoff + m * 2048 + k * 1024); } while (0)
#define PG8_LDB(dst, b, h) do { _Pragma("unroll") for (int n = 0; n < 2; ++n) _Pragma("unroll") for (int k = 0; k < 2; ++k) dst[n][k] = *(const LAS bf16x8*)(lds + PG8_SB(b, h) + boff + n * 2048 + k * 1024); } while (0)
#define PG8_CAT(f) __builtin_shufflevector(__builtin_bit_cast(v4i, (f)[0]), __builtin_bit_cast(v4i, (f)[1]), 0, 1, 2, 3, 4, 5, 6, 7)
#define PG8_MMA(ai, bj, At, Bt) do { __builtin_amdgcn_s_setprio(1); _Pragma("unroll") for (int m = 0; m < 4; ++m) _Pragma("unroll") for (int n = 0; n < 2; ++n) { \
        if constexpr (Epi::F8) { const v8i _b = PG8_CAT(Bt[n]), _a = PG8_CAT(At[m]); asm volatile("v_mfma_scale_f32_16x16x128_f8f6f4 %0, %1, %2, %0, %3, %3 op_sel_hi:[0,0,0]" : "+v"(acc[ai][bj][m][n]) : "v"(_b), "v"(_a), "v"(one8)); } \
        else { _Pragma("unroll") for (int k = 0; k < 2; ++k) acc[ai][bj][m][n] = __builtin_amdgcn_mfma_f32_16x16x32_bf16(Bt[n][k], At[m][k], acc[ai][bj][m][n], 0, 0, 0); } } __builtin_amdgcn_s_setprio(0); } while (0)
#define PG8_WAIT_V(n) asm volatile("s_waitcnt vmcnt(" #n ")" ::: "memory")
#define PG8_WAIT_L(n) asm volatile("s_waitcnt lgkmcnt(" #n ")" ::: "memory")
#define PG8_BAR __builtin_amdgcn_s_barrier()
#define PG8_SCHED __builtin_amdgcn_sched_barrier(0)
    Unit cur, nxt; int ui = 0;
    if (!S.next(0, cur)) return;
    int one8 = 0x7f7f7f7f; asm volatile("" : "+v"(one8));
    f32x4 acc[2][2][4][2];
#pragma unroll
    for (int a = 0; a < 2; ++a)
#pragma unroll
        for (int b = 0; b < 2; ++b)
#pragma unroll
            for (int m = 0; m < 4; ++m)
#pragma unroll
                for (int n = 0; n < 2; ++n) acc[a][b][m][n] = (f32x4){0.f, 0.f, 0.f, 0.f};
    bf16x8 At[4][2], B0[2][2], B1[2][2];
    unsigned offA[2][2], offN[2][2];
    S.a_off(cur, R, C, offA);
    const char* cB = S.b_base(cur);
    PG8_STAGEB(PG8_SB(0, 0), cB); PG8_STAGEB(PG8_SB(0, 1), cB + hstep); PG8_STAGEA(PG8_SA(0, 0), offA, 0, 0); PG8_STAGEA(PG8_SA(0, 1), offA, 1, 0);
    if (wr == 1) PG8_BAR;
    PG8_WAIT_V(2); PG8_BAR;
    PG8_STAGEB(PG8_SB(1, 0), cB + kstep); PG8_STAGEA(PG8_SA(1, 0), offA, 0, kstep); PG8_STAGEB(PG8_SB(1, 1), cB + hstep + kstep);
    PG8_WAIT_V(6); PG8_BAR;
    for (;;) {
        const bool has_next = S.next(ui + 1, nxt);
        const char* nB = has_next ? S.b_base(nxt) : cB;
        if (has_next) { S.a_off(nxt, R, C, offN); } else {
#pragma unroll
            for (int h = 0; h < 2; ++h)
#pragma unroll
                for (int i = 0; i < 2; ++i) offN[h][i] = offA[h][i]; }
        asm volatile("" : "+v"(offN[0][0]), "+v"(offN[0][1]), "+v"(offN[1][0]), "+v"(offN[1][1]));
#pragma unroll 1
        for (int t = 0; t < nt; t += 2) {
            const bool last = (t == nt - 2);
            const size_t k1 = (size_t)(t + 1) * kstep;
            const size_t k2 = last ? 0 : (size_t)(t + 2) * kstep, k3 = k2 + kstep;
            const char* b2 = last ? nB : cB + (size_t)(t + 2) * kstep; const char* b3 = b2 + kstep;
            unsigned o2[2][2];
#pragma unroll
            for (int h = 0; h < 2; ++h)
#pragma unroll
                for (int i = 0; i < 2; ++i) o2[h][i] = last ? offN[h][i] : offA[h][i];
            PG8_LDB(B0, 0, 0); PG8_LDB(B1, 0, 1); PG8_SCHED; PG8_LDA(At, 0, 0); PG8_STAGEA(PG8_SA(1, 1), offA, 1, k1);
            PG8_WAIT_V(8); PG8_WAIT_L(0); PG8_BAR; PG8_MMA(0, 0, At, B0); PG8_MMA(0, 1, At, B1); PG8_BAR; PG8_SCHED;
            PG8_LDA(At, 0, 1); PG8_STAGEB(PG8_SB(0, 0), b2); PG8_STAGEB(PG8_SB(0, 1), b2 + hstep); PG8_STAGEA(PG8_SA(0, 0), o2, 0, k2);
            PG8_WAIT_V(8); PG8_WAIT_L(0); PG8_BAR; PG8_MMA(1, 0, At, B0); PG8_MMA(1, 1, At, B1); PG8_BAR; PG8_SCHED;
            PG8_LDB(B0, 1, 0); PG8_LDB(B1, 1, 1); PG8_SCHED; PG8_LDA(At, 1, 0); PG8_STAGEA(PG8_SA(0, 1), o2, 1, k2);
            PG8_WAIT_V(8); PG8_WAIT_L(0); PG8_BAR; PG8_MMA(0, 0, At, B0); PG8_MMA(0, 1, At, B1); PG8_BAR; PG8_SCHED;
            PG8_LDA(At, 1, 1); PG8_STAGEB(PG8_SB(1, 0), b3); PG8_STAGEB(PG8_SB(1, 1), b3 + hstep); PG8_STAGEA(PG8_SA(1, 0), o2, 0, k3);
            PG8_WAIT_V(8); PG8_WAIT_L(0); PG8_BAR; PG8_MMA(1, 0, At, B0); PG8_MMA(1, 1, At, B1); PG8_BAR; PG8_SCHED;
        }
        if (wr == 0) PG8_BAR;
        if constexpr (Epi::F8) asm volatile("s_nop 15\n\ts_nop 7" ::: "memory");
        { int lz = lane; asm volatile("" : "+v"(lz));
          E(acc, cur, wr, wc, lz & 15, lz >> 4); }
        if (!has_next) break;
#pragma unroll
        for (int a = 0; a < 2; ++a)
#pragma unroll
            for (int b = 0; b < 2; ++b)
#pragma unroll
                for (int m = 0; m < 4; ++m)
#pragma unroll
                    for (int n = 0; n < 2; ++n) acc[a][b][m][n] = (f32x4){0.f, 0.f, 0.f, 0.f};
        cur = nxt; cB = nB; ++ui;
#pragma unroll
        for (int h = 0; h < 2; ++h)
#pragma unroll
            for (int i = 0; i < 2; ++i) offA[h][i] = offN[h][i];
        if (wr == 1) PG8_BAR;
    }
    PG8_WAIT_V(0);
    PG8_BAR;
#undef PG8_SA
#undef PG8_SB
#undef PG8_STAGEA
#undef PG8_STAGEB
#undef PG8_LDA
#undef PG8_LDB
#undef PG8_MMA
#undef PG8_CAT
#undef PG8_WAIT_V
#undef PG8_WAIT_L
#undef PG8_BAR
#undef PG8_SCHED
}
}

struct Frame {
    LAS unsigned char* lds;
    gu32* ctl; unsigned char* ws;
    int tid, lane, wave, vcu, G;
    const float *x, *c, *w_ada, *b_ada, *g_mix_pre, *g_mix_post, *w_in, *conv_w, *conv_b, *gaw, *gab, *gxw, *gxb, *lam, *pool_w, *pool_b, *pool_s, *w_out,
                *g_ffn_pre, *g_ffn_post, *router_w, *router_b, *w1, *b1, *w2, *b2;
    float* out; float* out2;
    float *modp, *CT, *gate, *sW1, *sW2, *scl; bf16 *GT, *WIN, *WOUT, *H, *U, *MIXIN, *MIX, *Y, *X1; unsigned char *H2, *W1T, *W2T, *ACT; unsigned* slot; int* list;
};
__device__ __forceinline__ float modv(const Frame& F, int b, int n) {
    const float* p = F.modp + b * 6144 + n;
    return ((p[0] + p[4 * 6144]) + (p[8 * 6144] + p[12 * 6144])) + F.b_ada[n];
}

struct TrJob { const float* W; bf16* WT; int ldn, nblk, K, mode; };
__device__ __forceinline__ void tr_load(const TrJob& j, int item, int lane, f32x4 (&v)[8]) {
    const int kb = item / j.nblk, nb = item % j.nblk; const float* p = j.W + (size_t)(64 * kb + (lane >> 3)) * j.ldn + 32 * nb + 4 * (lane & 7);
#pragma unroll
    for (int i = 0; i < 8; ++i) v[i] = *(const f32x4*)(p + (size_t)(8 * i) * j.ldn);
}
__device__ __forceinline__ void tr_put(LAS float* scr, int lane, const f32x4 (&v)[8]) {
#pragma unroll
    for (int i = 0; i < 8; ++i) { LAS float* s = scr + (8 * i + (lane >> 3)) * 33 + 4 * (lane & 7); s[0] = v[i][0]; s[1] = v[i][1]; s[2] = v[i][2]; s[3] = v[i][3]; }
}
__device__ __forceinline__ void tr_store(const TrJob& j, int item, int lane, LAS const float* scr) {
    const int kb = item / j.nblk, nb = item % j.nblk, k0 = 64 * kb, n0 = 32 * nb, c = lane & 7;
#pragma unroll
    for (int q = 0; q < 4; ++q) { const int n = (lane >> 3) + 8 * q; LAS const float* s = scr + (8 * c) * 33 + n;
        v4u o; o.x = pk2(s[0 * 33], s[1 * 33]); o.y = pk2(s[2 * 33], s[3 * 33]); o.z = pk2(s[4 * 33], s[5 * 33]); o.w = pk2(s[6 * 33], s[7 * 33]);
        const int orow = j.mode ? n0 + ((n & 1) ? 16 + (n >> 1) : (n >> 1)) : n0 + n;
        *(v4u*)(j.WT + (size_t)orow * j.K + k0 + 8 * c) = o; }
}
__device__ __forceinline__ bool tr_job(const Frame& F, int it, TrJob& j, int& item) {
    constexpr int I_IN = 16 * 32, I_OUT = 16 * 32;
    if (it < I_IN) { j = TrJob{F.w_in, F.WIN, INW, 32, D, 0}; item = it; return true; } it -= I_IN;
    if (it < I_OUT) { j = TrJob{F.w_out, F.WOUT, D, 32, D, 0}; item = it; return true; }
    return false;
}
__device__ __forceinline__ void strip_job(const Frame& F, int s, const float*& W, unsigned char*& WT, float*& SW, int& ldn, int& mode) {
    const bool is1 = s < 2048; const int s2 = is1 ? s : s - 2048; const int e = is1 ? (s2 >> 6) : (s2 >> 5), nb = is1 ? (s2 & 63) : (s2 & 31);
    const int rows = is1 ? DE2 : D;
    const size_t r0 = (size_t)e * rows + 32 * nb;
    const long d21 = F.w2 - F.w1;
    W = F.w1 + (is1 ? 0l : d21) + (size_t)e * D * rows + 32 * nb;
    WT = F.ws + (is1 ? WS_W1 : WS_W2) + r0 * 1024;
    SW = (float*)(F.ws + (is1 ? WS_SW1 : WS_SW2)) + r0;
    ldn = rows; mode = is1 ? 1 : 0;
}
__device__ __forceinline__ void strip_load(const float* W, int ldn, int wave, int lane, f32x4 (&v)[16]) {
    const float* p = W + (size_t)(128 * wave + (lane >> 3)) * ldn + 4 * (lane & 7);
#pragma unroll
    for (int i = 0; i < 16; ++i) v[i] = *(const f32x4*)(p + (size_t)(8 * i) * ldn);
}
template <int PROBE, bool PRE> __device__ __forceinline__ void p0_strips(Frame& F, int first, int step, int last, f32x4 (&va)[16]) {
    const int lane = F.lane;
    {
        const int w = F.wave;
        LAS float* scr = (LAS float*)(F.lds + w * 16896);
        LAS float* pm = (LAS float*)(F.lds + 8 * 16896);
        const int NSTRIPS = last;
        f32x4 vb[16];
        int par = 0;
#define STRIP_ISSUE(v, sidx) do { if ((sidx) < NSTRIPS) { const float* _W; unsigned char* _WT; float* _SW; int _ldn, _mode; strip_job(F, (sidx), _W, _WT, _SW, _ldn, _mode); strip_load(_W, _ldn, w, lane, v); } } while (0)
#define STRIP_PROCESS(v, sidx, nextv, nextidx) do { \
            unsigned char* cWT; float* cSW; int cmode; { const float* _W; int _ldn; strip_job(F, (sidx), _W, cWT, cSW, _ldn, cmode); } \
            f32x4 mx = {0.f, 0.f, 0.f, 0.f}; \
            _Pragma("unroll") for (int i = 0; i < 16; ++i) { LAS float* sp = scr + (8 * i + (lane >> 3)) * 33 + 4 * (lane & 7); sp[0] = v[i][0]; sp[1] = v[i][1]; sp[2] = v[i][2]; sp[3] = v[i][3]; \
                mx[0] = fmaxf(mx[0], fabsf(v[i][0])); mx[1] = fmaxf(mx[1], fabsf(v[i][1])); mx[2] = fmaxf(mx[2], fabsf(v[i][2])); mx[3] = fmaxf(mx[3], fabsf(v[i][3])); } \
            _Pragma("unroll") for (int x = 0; x < 4; ++x) { float m = mx[x]; m = fmaxf(m, __shfl_xor(m, 8)); m = fmaxf(m, __shfl_xor(m, 16)); m = fmaxf(m, __shfl_xor(m, 32)); mx[x] = m; } \
            if (lane < 8) *(LAS f32x4*)(pm + (par * 8 + w) * 32 + 4 * lane) = mx; \
            STRIP_ISSUE(nextv, nextidx); \
            asm volatile("s_waitcnt lgkmcnt(0)" ::: "memory"); __builtin_amdgcn_s_barrier(); asm volatile("" ::: "memory"); \
            float inv[2]; \
            _Pragma("unroll") for (int jj = 0; jj < 2; ++jj) { const int n = (lane >> 2) + 16 * jj; float am = 0.f; \
                _Pragma("unroll") for (int ww = 0; ww < 8; ++ww) am = fmaxf(am, pm[(par * 8 + ww) * 32 + n]); \
                const float sc = am > 0.f ? am * (1.0f / 448.0f) : 1.0f; inv[jj] = 1.0f / sc; \
                if (w == 0 && (lane & 3) == 0) (PROBE ? cSW + 168 * 1024 * 1024 : cSW)[cmode ? ((n & 1) ? 16 + (n >> 1) : (n >> 1)) : n] = sc; } \
            _Pragma("unroll") for (int tl = 0; tl < 2; ++tl) _Pragma("unroll") for (int jj = 0; jj < 2; ++jj) { const int n = (lane >> 2) + 16 * jj, c = lane & 3; LAS const float* sp = scr + (64 * tl + 16 * c) * 33 + n; const float iv = inv[jj]; \
                    v4u o; \
                    o.x = pk4_fp8(sp[0 * 33] * iv, sp[1 * 33] * iv, sp[2 * 33] * iv, sp[3 * 33] * iv); o.y = pk4_fp8(sp[4 * 33] * iv, sp[5 * 33] * iv, sp[6 * 33] * iv, sp[7 * 33] * iv); \
                    o.z = pk4_fp8(sp[8 * 33] * iv, sp[9 * 33] * iv, sp[10 * 33] * iv, sp[11 * 33] * iv); o.w = pk4_fp8(sp[12 * 33] * iv, sp[13 * 33] * iv, sp[14 * 33] * iv, sp[15 * 33] * iv); \
                    const int orow = cmode ? ((n & 1) ? 16 + (n >> 1) : (n >> 1)) : n; \
                    if (PROBE != 2) *(v4u*)(cWT + (PROBE ? (size_t)WS_END : (size_t)0) + (size_t)orow * 1024 + 128 * w + 64 * tl + 16 * c) = o; else if (o.x == 0x12345678u) *(v4u*)(cWT) = o; } \
            asm volatile("s_waitcnt lgkmcnt(0)" ::: "memory"); par ^= 1; } while (0)
        int st = first;
        if (!PRE) STRIP_ISSUE(va, st);
        STRIP_ISSUE(vb, st + step);
        while (st < NSTRIPS) {
            STRIP_PROCESS(va, st, va, st + 2 * step); st += step;
            if (st >= NSTRIPS) break;
            STRIP_PROCESS(vb, st, vb, st + 2 * step); st += step;
        }
#undef STRIP_ISSUE
#undef STRIP_PROCESS
    }
}
__device__ __forceinline__ void p0_prologue(Frame& F) {
    const int tid = F.tid, lane = F.lane;
    if (F.G == 256) {
        const int it = blockIdx.x, kq = it >> 6, nc = it & 63;
        const float ca0 = F.c[(tid >> 8) * D + 256 * kq + (tid & 255)], ca1 = F.c[((tid + 512) >> 8) * D + 256 * kq + (tid & 255)];
        const int c4 = tid % 24, kl = tid / 24;
        f32x4 wv[16];
        { const float* wp = F.w_ada + (size_t)(256 * kq + (tid < 384 ? kl : 0)) * 6144 + 96 * nc + 4 * (tid < 384 ? c4 : 0);
#pragma unroll
          for (int j = 0; j < 16; ++j) wv[j] = *(const f32x4*)(wp + (size_t)(16 * j) * 6144); }
        float wb[4];
#pragma unroll
        for (int j = 0; j < 4; ++j) { const int i = tid + 512 * j; wb[j] = F.w_in[(size_t)(4 * it + (i >> 9)) * INW + 1024 + (i & 511)]; }
        const int gw = F.vcu * NWAVES + F.wave; TrJob tj; int titem = 0; f32x4 dv[8];
        const bool hasD = tr_job(F, gw < 1024 ? gw : 0, tj, titem) && gw < 1024;
        tr_load(tj, titem, lane, dv);
        const int gt = blockIdx.x * NTHREADS + tid; const bool hasG = gt < 64 * 17 * 64;
        const int gl = gt & 63, gs = (gt >> 6) % 17, gun = hasG ? gt / (64 * 17) : 0, gh = gun >> 3, go = gun & 7, gm = gl & 31, gk0 = 8 * (gl >> 5);
        float cwv[8], gvv[8];
#pragma unroll
        for (int jj = 0; jj < 8; ++jj) { const int i = 16 * (gs & 3) + gk0 + jj, tap = (gs < 16) ? (gs >> 2) : 0; cwv[jj] = F.conv_w[tap * LRU + 64 * gh + i];
            const float* gp = (gm < 8 ? F.gaw : F.gxw) + (size_t)(gh * 64 + i) * 64 + 8 * go + (gm & 7); gvv[jj] = *gp; }
        const int cch = blockIdx.x * NWAVES + F.wave; const bool hasC = cch < LRU; const int chh = hasC ? (cch >> 6) : 0, cjn = cch & 63;
        const float ccb = F.conv_b[64 * chh + lane], cga = F.gaw[(size_t)(chh * 64 + lane) * 64 + cjn], cgx = F.gxw[(size_t)(chh * 64 + lane) * 64 + cjn];
        f32x4 sva[16];
        if (F.vcu < NS_P0) { const float* sW_; unsigned char* sWT_; float* sSW_; int sldn_, smode_; strip_job(F, F.vcu, sW_, sWT_, sSW_, sldn_, smode_); strip_load(sW_, sldn_, F.wave, lane, sva); }
        LAS float* cact = (LAS float*)F.lds; LAS float* red = (LAS float*)(F.lds + 4096);
        cact[tid] = ca0 / (1.0f + __expf(-ca0)); cact[tid + 512] = ca1 / (1.0f + __expf(-ca1));
        __syncthreads();
        if (tid < 384) {
            f32x4 a0 = {0.f, 0.f, 0.f, 0.f}, a1 = a0, a2 = a0, a3 = a0;
#pragma unroll
            for (int j = 0; j < 16; ++j) { const int k = kl + 16 * j; a0 += cact[k] * wv[j]; a1 += cact[256 + k] * wv[j]; a2 += cact[512 + k] * wv[j]; a3 += cact[768 + k] * wv[j]; }
            *(LAS f32x4*)(red + (kl * 4 + 0) * 96 + 4 * c4) = a0; *(LAS f32x4*)(red + (kl * 4 + 1) * 96 + 4 * c4) = a1;
            *(LAS f32x4*)(red + (kl * 4 + 2) * 96 + 4 * c4) = a2; *(LAS f32x4*)(red + (kl * 4 + 3) * 96 + 4 * c4) = a3;
        }
        __syncthreads();
        if (tid < 384) { const int b = tid / 96, col = tid % 96; float sm = 0.f;
#pragma unroll
            for (int k2 = 0; k2 < 16; ++k2) sm += red[(k2 * 4 + b) * 96 + col];
            F.modp[(kq * 4 + b) * 6144 + 96 * nc + col] = sm; }
        __syncthreads();
        { LAS float* win = (LAS float*)F.lds;
#pragma unroll
          for (int j = 0; j < 4; ++j) win[tid + 512 * j] = wb[j];
          __syncthreads();
          const int g = tid >> 7, d = tid & 127; float a0 = 0.f, a1 = 0.f, a2 = 0.f, a3 = 0.f;
          const float* pw = F.pool_w + (size_t)g * 128 * 128 + d; LAS const float* wl = win + 128 * g;
#pragma unroll 16
          for (int cc = 0; cc < 128; ++cc) { const float p = pw[cc * 128]; a0 += wl[cc] * p; a1 += wl[512 + cc] * p; a2 += wl[1024 + cc] * p; a3 += wl[1536 + cc] * p; }
          v2u o; o.x = pk2(a0, a1); o.y = pk2(a2, a3);
          *(v2u*)(F.WIN + (size_t)(1024 + tid) * D + 4 * it) = o;
          __syncthreads(); }
        if (hasG) { float v[8];
#pragma unroll
            for (int jj = 0; jj < 8; ++jj) { const int kk = gk0 + jj; float val = 0.f;
                if (gs < 16) { const int i = 16 * (gs & 3) + kk; if (gm < 16) val = cwv[jj] * gvv[jj]; else if (gm < 24) val = (i == 8 * go + gm - 16) ? cwv[jj] : 0.f; }
                else if (gm >= 24) val = (kk == 8 * (go & 1) + gm - 24) ? 1.0f : 0.f;
                v[jj] = val; }
            v4u wq; wq.x = pk2(v[0], v[1]); wq.y = pk2(v[2], v[3]); wq.z = pk2(v[4], v[5]); wq.w = pk2(v[6], v[7]);
            *(v4u*)(F.GT + (size_t)gt * 8) = wq; }
        { const float sa = wave_sum(ccb * cga), sx = wave_sum(ccb * cgx);
          if (hasC && lane == 0) { const float lm = F.lam[cch]; const float sp = log1pf(__expf(-lm));
            f32x4 o; o[0] = sa + F.gab[cch]; o[1] = sx + F.gxb[cch]; o[2] = F.conv_b[cch]; o[3] = -8.0f * sp * LOG2E;
            *(f32x4*)(F.CT + 4 * cch) = o; } }
        if (hasD) { LAS float* scr = (LAS float*)(F.lds + F.wave * 8448);
            tr_put(scr, lane, dv); LDS_WAIT(); asm volatile("" ::: "memory");
            tr_store(tj, titem, lane, scr); LDS_WAIT(); asm volatile("" ::: "memory"); }
        __syncthreads();
        p0_strips<0, true>(F, F.vcu, F.G, NS_P0, sva);
        return;
    }
    for (int it = blockIdx.x; it < 256; it += F.G) {
        LAS float* cact = (LAS float*)F.lds; LAS float* red = (LAS float*)(F.lds + 4096);
        const int kq = it >> 6, nc = it & 63;
        for (int i = tid; i < 1024; i += NTHREADS) { const float cv = F.c[(i >> 8) * D + 256 * kq + (i & 255)]; cact[i] = cv / (1.0f + __expf(-cv)); }
        __syncthreads();
        if (tid < 384) {
            const int c4 = tid % 24, kl = tid / 24;
            f32x4 a0 = {0.f, 0.f, 0.f, 0.f}, a1 = a0, a2 = a0, a3 = a0;
            const float* wp = F.w_ada + (size_t)(256 * kq + kl) * 6144 + 96 * nc + 4 * c4;
            f32x4 wv[16];
#pragma unroll
            for (int j = 0; j < 16; ++j) wv[j] = *(const f32x4*)(wp + (size_t)(16 * j) * 6144);
#pragma unroll
            for (int j = 0; j < 16; ++j) { const int k = kl + 16 * j; a0 += cact[k] * wv[j]; a1 += cact[256 + k] * wv[j]; a2 += cact[512 + k] * wv[j]; a3 += cact[768 + k] * wv[j]; }
            *(LAS f32x4*)(red + (kl * 4 + 0) * 96 + 4 * c4) = a0; *(LAS f32x4*)(red + (kl * 4 + 1) * 96 + 4 * c4) = a1;
            *(LAS f32x4*)(red + (kl * 4 + 2) * 96 + 4 * c4) = a2; *(LAS f32x4*)(red + (kl * 4 + 3) * 96 + 4 * c4) = a3;
        }
        __syncthreads();
        if (tid < 384) { const int b = tid / 96, col = tid % 96; float s = 0.f;
#pragma unroll
            for (int kl = 0; kl < 16; ++kl) s += red[(kl * 4 + b) * 96 + col];
            F.modp[(kq * 4 + b) * 6144 + 96 * nc + col] = s; }
        __syncthreads();
    }
    for (int it = blockIdx.x; it < 256; it += F.G) {
        LAS float* win = (LAS float*)F.lds;
        for (int i = tid; i < 2048; i += NTHREADS) win[i] = F.w_in[(size_t)(4 * it + (i >> 9)) * INW + 1024 + (i & 511)];
        __syncthreads();
        { const int g = tid >> 7, d = tid & 127; float a0 = 0.f, a1 = 0.f, a2 = 0.f, a3 = 0.f;
          const float* pw = F.pool_w + (size_t)g * 128 * 128 + d; LAS const float* wl = win + 128 * g;
#pragma unroll 16
          for (int cc = 0; cc < 128; ++cc) { const float p = pw[cc * 128]; a0 += wl[cc] * p; a1 += wl[512 + cc] * p; a2 += wl[1024 + cc] * p; a3 += wl[1536 + cc] * p; }
          v2u o; o.x = pk2(a0, a1); o.y = pk2(a2, a3);
          *(v2u*)(F.WIN + (size_t)(1024 + tid) * D + 4 * it) = o; }
        __syncthreads();
    }
    for (int gt = blockIdx.x * NTHREADS + tid; gt < 64 * 17 * 64; gt += F.G * NTHREADS) {
        const int l = gt & 63, s = (gt >> 6) % 17, un = gt / (64 * 17), h = un >> 3, o = un & 7, m = l & 31, kk0 = 8 * (l >> 5);
        float v[8];
#pragma unroll
        for (int jj = 0; jj < 8; ++jj) { const int kk = kk0 + jj; float val = 0.f;
            if (s < 16) { const int tap = s >> 2, i = 16 * (s & 3) + kk; const float cw = F.conv_w[tap * LRU + 64 * h + i];
                if (m < 8) val = cw * F.gaw[(size_t)(h * 64 + i) * 64 + 8 * o + m];
                else if (m < 16) val = cw * F.gxw[(size_t)(h * 64 + i) * 64 + 8 * o + m - 8];
                else if (m < 24) val = (i == 8 * o + m - 16) ? cw : 0.f;
            } else if (m >= 24) val = (kk == 8 * (o & 1) + m - 24) ? 1.0f : 0.f;
            v[jj] = val; }
        v4u w; w.x = pk2(v[0], v[1]); w.y = pk2(v[2], v[3]); w.z = pk2(v[4], v[5]); w.w = pk2(v[6], v[7]);
        *(v4u*)(F.GT + (size_t)gt * 8) = w;
    }
    for (int ch = blockIdx.x * NWAVES + F.wave; ch < LRU; ch += F.G * NWAVES) {
        const int h = ch >> 6, jn = ch & 63; const float cb = F.conv_b[64 * h + lane];
        const float sa = wave_sum(cb * F.gaw[(size_t)(h * 64 + lane) * 64 + jn]), sx = wave_sum(cb * F.gxw[(size_t)(h * 64 + lane) * 64 + jn]);
        if (lane == 0) { const float lm = F.lam[ch]; const float sp = log1pf(__expf(-lm));
            f32x4 o; o[0] = sa + F.gab[ch]; o[1] = sx + F.gxb[ch]; o[2] = F.conv_b[ch]; o[3] = -8.0f * sp * LOG2E;
            *(f32x4*)(F.CT + 4 * ch) = o; }
    }
    {
        LAS float* scr = (LAS float*)(F.lds + F.wave * 8448);
        const int gw = F.vcu * NWAVES + F.wave, NGW = F.G * NWAVES;
        constexpr int NITEMS = 512 + 512;
        TrJob j; int item = 0; f32x4 v[8];
        for (int it = gw; it < NITEMS; it += NGW) {
            if (!tr_job(F, it, j, item)) break;
            tr_load(j, item, lane, v); tr_put(scr, lane, v);
            LDS_WAIT(); asm volatile("" ::: "memory");
            tr_store(j, item, lane, scr);
            LDS_WAIT(); asm volatile("" ::: "memory");
        }
    }
    __syncthreads();
    { f32x4 sva[16]; p0_strips<0, false>(F, F.vcu, F.G, NS_P0, sva); }
}

__device__ __forceinline__ void p1_prenorm(Frame& F) {
    LAS float* cH = (LAS float*)F.lds; LAS float* sh = cH + D;
    for (int rb = F.vcu; rb < T / 64; rb += F.G) {
        const int row0 = 64 * rb, b = row0 / SEQ;
        __syncthreads();
        for (int i = F.tid; i < D; i += NTHREADS) { cH[i] = F.g_mix_pre[i] * (1.0f + modv(F, b, D + i)); sh[i] = modv(F, b, i); }
        __syncthreads();
        {   const int rbase = row0 + 8 * F.wave; f32x4 xb[2][4];
#pragma unroll
            for (int q = 0; q < 4; ++q) xb[0][q] = *((const f32x4*)(F.x + (size_t)rbase * D) + F.lane + 64 * q);
#pragma unroll
            for (int j = 0; j < 8; ++j) {
                const int cb = j & 1, row = rbase + j;
                if (j + 1 < 8) {
#pragma unroll
                    for (int q = 0; q < 4; ++q) xb[cb ^ 1][q] = *((const f32x4*)(F.x + (size_t)(row + 1) * D) + F.lane + 64 * q); }
                f32x4 v[4]; float ss = 0.f;
#pragma unroll
                for (int q = 0; q < 4; ++q) { v[q] = xb[cb][q]; ss += (v[q][0] * v[q][0] + v[q][1] * v[q][1]) + (v[q][2] * v[q][2] + v[q][3] * v[q][3]); }
                const float rstd = rsqrtf(wave_sum(ss) * (1.0f / D) + EPS);
                v2u* o8 = (v2u*)(F.H + (size_t)row * D) + F.lane;
#pragma unroll
                for (int q = 0; q < 4; ++q) { const f32x4 cc = *(LAS const f32x4*)(cH + 4 * F.lane + 256 * q), ss4 = *(LAS const f32x4*)(sh + 4 * F.lane + 256 * q);
                    const f32x4 hv = v[q] * rstd * cc + ss4; v2u w; w.x = pk2(hv[0], hv[1]); w.y = pk2(hv[2], hv[3]); o8[64 * q] = w; }
            }
        }
    }
}

template <int WD> __device__ __forceinline__ void pool_run(const bf16* vp, bf16* op, int t, const float (&pb)[8], const float (&ps)[8]) {
    constexpr int NR = WD + 7;
    v4u r[NR];
#pragma unroll
    for (int k = 0; k < NR; ++k) { r[k] = (v4u){0u, 0u, 0u, 0u}; if (t - (WD - 1) + k >= 0) r[k] = *(const v4u*)(vp + (long)(k - (WD - 1)) * INW); }
    float s[8] = {0.f, 0.f, 0.f, 0.f, 0.f, 0.f, 0.f, 0.f};
#pragma unroll
    for (int k = 0; k < WD - 1; ++k) { if ((k & 3) == 3) __builtin_amdgcn_sched_barrier(0); s[0] += bf_lo(r[k].x); s[1] += bf_hi(r[k].x); s[2] += bf_lo(r[k].y); s[3] += bf_hi(r[k].y); s[4] += bf_lo(r[k].z); s[5] += bf_hi(r[k].z); s[6] += bf_lo(r[k].w); s[7] += bf_hi(r[k].w); }
#pragma unroll
    for (int i = 0; i < 8; ++i) {
        const v4u q = r[WD - 1 + i];
        const float cv[8] = {bf_lo(q.x), bf_hi(q.x), bf_lo(q.y), bf_hi(q.y), bf_lo(q.z), bf_hi(q.z), bf_lo(q.w), bf_hi(q.w)};
        const int cnt = (t + i + 1) < WD ? (t + i + 1) : WD; const float rc = 1.0f / (float)cnt;
        float ov[8];
#pragma unroll
        for (int x = 0; x < 8; ++x) { s[x] += cv[x]; ov[x] = (s[x] * rc - cv[x] + pb[x]) * ps[x]; }
        v4u ow; ow.x = pk2(ov[0], ov[1]); ow.y = pk2(ov[2], ov[3]); ow.z = pk2(ov[4], ov[5]); ow.w = pk2(ov[6], ov[7]);
        *(v4u*)(op + (size_t)i * D) = ow;
        const v4u z = r[i];
        s[0] -= bf_lo(z.x); s[1] -= bf_hi(z.x); s[2] -= bf_lo(z.y); s[3] -= bf_hi(z.y); s[4] -= bf_lo(z.z); s[5] -= bf_hi(z.z); s[6] -= bf_lo(z.w); s[7] -= bf_hi(z.w);
        __builtin_amdgcn_sched_barrier(0);
    }
}
constexpr int XS_PITCH = 144, P3_AB = 74752, P3_YS = 123904;
__device__ __forceinline__ void p3_mixer(Frame& F) {
    const int tid = F.tid, lane = F.lane, w = F.wave, hh = lane >> 5, tl = lane & 31;
    LAS unsigned char* XS = F.lds;
    LAS float* ABa = (LAS float*)(F.lds + P3_AB); LAS float* ABb = ABa + 8 * 512; LAS float* ABg = ABb + 8 * 512;
    LAS bf16* YS = (LAS bf16*)(F.lds + P3_YS);
    for (int unit = F.vcu; unit < 256; unit += F.G) {
        const int b = unit >> 6, h = (unit >> 3) & 7, o = unit & 7;
        bf16x8 Af[17];
        { const bf16x8* gt = (const bf16x8*)F.GT + (size_t)((h * 8 + o) * 17) * 64 + lane;
#pragma unroll
          for (int s = 0; s < 17; ++s) Af[s] = gt[s * 64]; }
        float br[4], bi[4], bx[4], kc[4];
#pragma unroll
        for (int x = 0; x < 4; ++x) { const f32x4 c4 = *(const f32x4*)(F.CT + 4 * (64 * h + 8 * o + 4 * hh + x)); br[x] = c4[0]; bi[x] = c4[1]; bx[x] = c4[2]; kc[x] = c4[3]; }
        float carry = 0.f;
        const bf16* Ub = F.U + (size_t)(b * SEQ) * INW;
        __syncthreads();
        if (tid < 24) *(LAS v4u*)(XS + (tid >> 3) * XS_PITCH + (tid & 7) * 16) = (v4u){0u, 0u, 0u, 0u};
        v4u xr[8];
#pragma unroll
        for (int j = 0; j < 8; ++j) { const int p = tid + 512 * j; xr[j] = *(const v4u*)(Ub + (size_t)(p >> 3) * INW + 64 * h + 8 * (p & 7)); }
        for (int ck = 0; ck < 8; ++ck) {
            const int t0 = 512 * ck;
#pragma unroll
            for (int j = 0; j < 8; ++j) { const int p = tid + 512 * j; *(LAS v4u*)(XS + (3 + (p >> 3)) * XS_PITCH + (p & 7) * 16) = xr[j]; }
            bf16x8 gaf[2];
#pragma unroll
            for (int tile = 0; tile < 2; ++tile) gaf[tile] = *(const bf16x8*)(Ub + (size_t)(t0 + 64 * w + 32 * tile + tl) * INW + 512 + 64 * h + 16 * (o >> 1) + 8 * hh);
            __syncthreads();
            if (ck < 7) {
#pragma unroll
                for (int j = 0; j < 8; ++j) { const int p = tid + 512 * j; xr[j] = *(const v4u*)(Ub + (size_t)(t0 + 512 + (p >> 3)) * INW + 64 * h + 8 * (p & 7)); }
            }
#pragma unroll
            for (int tile = 0; tile < 2; ++tile) {
                const int tt = 64 * w + 32 * tile + tl;
                f32x16 acc;
#pragma unroll
                for (int i = 0; i < 16; ++i) acc[i] = 0.f;
#pragma unroll
                for (int s = 0; s < 16; ++s) { const int tap = s >> 2, q = s & 3;
                    const bf16x8 bf = *(LAS const bf16x8*)(XS + (tt + 3 - tap) * XS_PITCH + 32 * q + 16 * hh);
                    acc = __builtin_amdgcn_mfma_f32_32x32x16_bf16(Af[s], bf, acc, 0, 0, 0); if ((s & 3) == 3) __builtin_amdgcn_sched_barrier(0); }
                acc = __builtin_amdgcn_mfma_f32_32x32x16_bf16(Af[16], gaf[tile], acc, 0, 0, 0);
#pragma unroll
                for (int x = 0; x < 4; ++x) {
                    const float r = fast_sigmoid(acc[x] + br[x]), ig = fast_sigmoid(acc[4 + x] + bi[x]), xc = acc[8 + x] + bx[x];
                    const float a = __builtin_amdgcn_exp2f(r * kc[x]);
                    const float mult = __builtin_amdgcn_sqrtf(fmaxf(1.0f - a * a, 0.f));
                    const int idx = (4 * hh + x) * 512 + tt;
                    ABa[idx] = a; ABb[idx] = mult * ig * xc; ABg[idx] = gelu_tanh(acc[12 + x]);
                }
            }
            __syncthreads();
            if (tid < 24) *(LAS v4u*)(XS + (tid >> 3) * XS_PITCH + (tid & 7) * 16) = *(LAS const v4u*)(XS + (512 + (tid >> 3)) * XS_PITCH + (tid & 7) * 16);
            {
                const f32x4 a0 = *(LAS const f32x4*)(ABa + w * 512 + 8 * lane), a1 = *(LAS const f32x4*)(ABa + w * 512 + 8 * lane + 4);
                const f32x4 b0 = *(LAS const f32x4*)(ABb + w * 512 + 8 * lane), b1 = *(LAS const f32x4*)(ABb + w * 512 + 8 * lane + 4);
                const f32x4 g0 = *(LAS const f32x4*)(ABg + w * 512 + 8 * lane), g1 = *(LAS const f32x4*)(ABg + w * 512 + 8 * lane + 4);
                float av[8] = {a0[0], a0[1], a0[2], a0[3], a1[0], a1[1], a1[2], a1[3]}, bv[8] = {b0[0], b0[1], b0[2], b0[3], b1[0], b1[1], b1[2], b1[3]};
                float gv[8] = {g0[0], g0[1], g0[2], g0[3], g1[0], g1[1], g1[2], g1[3]};
                float hl[8], pc[8]; float hcur = 0.f, pcur = 1.f;
#pragma unroll
                for (int i = 0; i < 8; ++i) { hcur = av[i] * hcur + bv[i]; pcur *= av[i]; hl[i] = hcur; pc[i] = pcur; }
                float A = pcur, B = hcur;
#pragma unroll
                for (int d = 1; d < 64; d <<= 1) { const float Ap = __shfl_up(A, d), Bp = __shfl_up(B, d); if (lane >= d) { B = A * Bp + B; A = A * Ap; } }
                float Ae = __shfl_up(A, 1), Be = __shfl_up(B, 1); if (lane == 0) { Ae = 1.f; Be = 0.f; }
                const float hin = Ae * carry + Be;
                float hv[8];
#pragma unroll
                for (int i = 0; i < 8; ++i) hv[i] = hl[i] + pc[i] * hin;
                carry = __shfl(hv[7], 63);
                { v4u yw; yw.x = pk2(hv[0] * gv[0], hv[1] * gv[1]); yw.y = pk2(hv[2] * gv[2], hv[3] * gv[3]); yw.z = pk2(hv[4] * gv[4], hv[5] * gv[5]); yw.w = pk2(hv[6] * gv[6], hv[7] * gv[7]);
                  *(LAS v4u*)(YS + w * 512 + 8 * lane) = yw; }
            }
            __syncthreads();
            { unsigned y[8];
#pragma unroll
              for (int c8 = 0; c8 < 8; ++c8) y[c8] = YS[c8 * 512 + tid];
              v4u ow; ow.x = y[0] | (y[1] << 16); ow.y = y[2] | (y[3] << 16); ow.z = y[4] | (y[5] << 16); ow.w = y[6] | (y[7] << 16);
              *(v4u*)(F.MIXIN + (size_t)(b * SEQ + t0 + tid) * D + 64 * h + 8 * o) = ow; }
        }
    }
    for (int it = F.vcu; it < 256; it += F.G) {
        int lv = lane; asm volatile("" : "+v"(lv));
        const int g = w & 3, cg = 16 * g + (lv & 15), run = it * 8 + (w >> 2) * 4 + (lv >> 4), row0 = 8 * run, t = row0 & (SEQ - 1);
        const bf16* vp = F.U + (size_t)row0 * INW + 1024 + 8 * cg; bf16* op = F.MIXIN + (size_t)row0 * D + 512 + 8 * cg;
        float pb[8], ps[8];
        { const f32x4 pb0 = *(const f32x4*)(F.pool_b + 8 * cg), pb1 = *(const f32x4*)(F.pool_b + 8 * cg + 4), ps0 = *(const f32x4*)(F.pool_s + 8 * cg), ps1 = *(const f32x4*)(F.pool_s + 8 * cg + 4);
#pragma unroll
          for (int x = 0; x < 4; ++x) { pb[x] = pb0[x]; pb[4 + x] = pb1[x]; ps[x] = ps0[x]; ps[4 + x] = ps1[x]; } }
        if (g == 0) pool_run<2>(vp, op, t, pb, ps); else if (g == 1) pool_run<4>(vp, op, t, pb, ps); else if (g == 2) pool_run<8>(vp, op, t, pb, ps); else pool_run<16>(vp, op, t, pb, ps);
    }
}

constexpr int P5_HL_PITCH = 4112;
constexpr int P5_HL = 0, P5_PART = 16 * P5_HL_PITCH, P5_LOG = P5_PART + 8 * 16 * 32 * 4;
constexpr int P5_VEC = AUX_OFF;
constexpr int P5_MISC = LDSCTL_OFF + 64;
static_assert(P5_MISC + 2304 + 256 <= LDS_BYTES && P5_LOG + 2048 <= RING_BYTES, "LDS map");
__device__ __forceinline__ void p5_rows(Frame& F) {
    const int tid = F.tid, lane = F.lane, w = F.wave;
    LAS unsigned char* HL = F.lds + P5_HL; LAS float* PART = (LAS float*)(F.lds + P5_PART); LAS float* LOG = (LAS float*)(F.lds + P5_LOG);
    LAS float* cA = (LAS float*)(F.lds + P5_VEC); LAS float* cB = cA + D; LAS float* shF = cB + D;
    LAS int* lcnt = (LAS int*)(F.lds + P5_MISC); LAS int* lbase = lcnt + 32; LAS int* rowe = lbase + 32; LAS int* rowr = rowe + 256; LAS float* rows_s = (LAS float*)(rowr + 256);
    bf16x8 Bh[4][2], Bl[4][2];
#pragma unroll
    for (int s4 = 0; s4 < 4; ++s4)
#pragma unroll
        for (int nb = 0; nb < 2; ++nb) { unsigned hw[4], lw[4];
#pragma unroll
            for (int jj = 0; jj < 4; ++jj) { const int k = 128 * w + 32 * s4 + 8 * (lane >> 4) + 2 * jj; const float v0 = F.router_w[(size_t)k * NE + 16 * nb + (lane & 15)], v1 = F.router_w[(size_t)(k + 1) * NE + 16 * nb + (lane & 15)];
                const unsigned h = pk2(v0, v1); hw[jj] = h; lw[jj] = pk2(v0 - bf_lo(h), v1 - bf_hi(h)); }
            Bh[s4][nb] = __builtin_bit_cast(bf16x8, (v4u){hw[0], hw[1], hw[2], hw[3]}); Bl[s4][nb] = __builtin_bit_cast(bf16x8, (v4u){lw[0], lw[1], lw[2], lw[3]}); }
    for (int rb = F.vcu; rb < T / 64; rb += F.G) {
        const int row0 = 64 * rb, b = row0 / SEQ;
        __syncthreads();
        for (int i = tid; i < D; i += NTHREADS) { cA[i] = modv(F, b, 2 * D + i) * F.g_mix_post[i]; cB[i] = F.g_ffn_pre[i] * (1.0f + modv(F, b, 4 * D + i)); shF[i] = modv(F, b, 3 * D + i); }
        if (tid < 32) lcnt[tid] = 0;
        __syncthreads();
#pragma unroll 1
        for (int ps = 0; ps < 4; ++ps) {
#pragma unroll
            for (int rr = 0; rr < 2; ++rr) {
                const int rl = 16 * ps + 2 * w + rr, row = row0 + rl;
                float hA[16];
                f32x4 xv[4], mv[4]; float ss = 0.f;
#pragma unroll
                for (int q = 0; q < 4; ++q) { xv[q] = *((const f32x4*)(F.x + (size_t)row * D) + lane + 64 * q); const v2u mw = *((const v2u*)(F.MIX + (size_t)row * D) + lane + 64 * q);
                    mv[q] = (f32x4){bf_lo(mw.x), bf_hi(mw.x), bf_lo(mw.y), bf_hi(mw.y)}; ss += (mv[q][0] * mv[q][0] + mv[q][1] * mv[q][1]) + (mv[q][2] * mv[q][2] + mv[q][3] * mv[q][3]); }
                const float rs = rsqrtf(wave_sum(ss) * (1.0f / D) + EPS); float s1 = 0.f;
#pragma unroll
                for (int q = 0; q < 4; ++q) { const f32x4 ca = *(LAS const f32x4*)(cA + 4 * lane + 256 * q); xv[q] = xv[q] + ca * (mv[q] * rs);
                    { v2u xw; xw.x = pk2(xv[q][0], xv[q][1]); xw.y = pk2(xv[q][2], xv[q][3]); *((v2u*)(F.X1 + (size_t)row * D) + lane + 64 * q) = xw; } s1 += (xv[q][0] * xv[q][0] + xv[q][1] * xv[q][1]) + (xv[q][2] * xv[q][2] + xv[q][3] * xv[q][3]); }
                const float r1 = rsqrtf(wave_sum(s1) * (1.0f / D) + EPS);
#pragma unroll
                for (int q = 0; q < 4; ++q) { const f32x4 cb = *(LAS const f32x4*)(cB + 4 * lane + 256 * q), sf = *(LAS const f32x4*)(shF + 4 * lane + 256 * q);
                    const f32x4 hv = xv[q] * r1 * cb + sf;
                    hA[4 * q + 0] = hv[0]; hA[4 * q + 1] = hv[1]; hA[4 * q + 2] = hv[2]; hA[4 * q + 3] = hv[3]; }
                float am = 0.f;
#pragma unroll
                for (int i = 0; i < 16; ++i) am = fmaxf(am, fabsf(hA[i]));
#pragma unroll
                for (int o = 1; o < 64; o <<= 1) am = fmaxf(am, __shfl_xor(am, o));
                const float sc = am > 0.f ? am * (1.0f / 448.0f) : 1.0f, iv = 1.0f / sc;
                if (lane == 0) rows_s[rl] = sc;
                LAS unsigned char* hr = HL + (2 * w + rr) * P5_HL_PITCH + 8 * lane;
#pragma unroll
                for (int q = 0; q < 4; ++q) { *((unsigned*)(F.H2 + (size_t)row * D) + lane + 64 * q) = pk4_fp8(hA[4 * q] * iv, hA[4 * q + 1] * iv, hA[4 * q + 2] * iv, hA[4 * q + 3] * iv);
                    const unsigned h0 = pk2(hA[4 * q], hA[4 * q + 1]), h1 = pk2(hA[4 * q + 2], hA[4 * q + 3]);
                    const unsigned l0 = pk2(hA[4 * q] - bf_lo(h0), hA[4 * q + 1] - bf_hi(h0)), l1 = pk2(hA[4 * q + 2] - bf_lo(h1), hA[4 * q + 3] - bf_hi(h1));
                    *(LAS v2u*)(hr + 512 * q) = (v2u){h0, h1}; *(LAS v2u*)(hr + 2048 + 512 * q) = (v2u){l0, l1}; }
            }
            __syncthreads();
            {   f32x4 acc0 = {0.f, 0.f, 0.f, 0.f}, acc1 = acc0;
                LAS const unsigned char* ap = HL + (lane & 15) * P5_HL_PITCH + 2 * (128 * w + 8 * (lane >> 4));
#pragma unroll
                for (int s4 = 0; s4 < 4; ++s4) { const bf16x8 ah = *(LAS const bf16x8*)(ap + 64 * s4), al = *(LAS const bf16x8*)(ap + 2048 + 64 * s4);
                    acc0 = __builtin_amdgcn_mfma_f32_16x16x32_bf16(ah, Bh[s4][0], acc0, 0, 0, 0); acc1 = __builtin_amdgcn_mfma_f32_16x16x32_bf16(ah, Bh[s4][1], acc1, 0, 0, 0);
                    acc0 = __builtin_amdgcn_mfma_f32_16x16x32_bf16(ah, Bl[s4][0], acc0, 0, 0, 0); acc1 = __builtin_amdgcn_mfma_f32_16x16x32_bf16(ah, Bl[s4][1], acc1, 0, 0, 0);
                    acc0 = __builtin_amdgcn_mfma_f32_16x16x32_bf16(al, Bh[s4][0], acc0, 0, 0, 0); acc1 = __builtin_amdgcn_mfma_f32_16x16x32_bf16(al, Bh[s4][1], acc1, 0, 0, 0); }
#pragma unroll
                for (int rg = 0; rg < 4; ++rg) { LAS float* pp = PART + (w * 16 + 4 * (lane >> 4) + rg) * 32 + (lane & 15); pp[0] = acc0[rg]; pp[16] = acc1[rg]; }
            }
            __syncthreads();
            { float sum = F.router_b[tid & 31];
#pragma unroll
              for (int ww = 0; ww < 8; ++ww) sum += PART[ww * 512 + tid];
              LOG[tid] = sum; }
            __syncthreads();
            {
                const int rl = 16 * ps + 2 * w + (lane >> 5), row = row0 + rl, me = lane & 31;
                float val = LOG[(2 * w + (lane >> 5)) * 32 + me];
                float tv[4]; int te[4];
#pragma unroll
                for (int k = 0; k < 4; ++k) { float m = val; int mi = me;
#pragma unroll
                    for (int d = 1; d < 32; d <<= 1) { const float om = __shfl_xor(m, d); const int oi = __shfl_xor(mi, d); if (om > m || (om == m && oi < mi)) { m = om; mi = oi; } }
                    tv[k] = m; te[k] = mi; if (me == mi) val = -3.0e38f; }
                const float e1 = __expf(tv[1] - tv[0]), e2 = __expf(tv[2] - tv[0]), e3 = __expf(tv[3] - tv[0]); const float inv = 1.0f / (1.0f + e1 + e2 + e3);
                if (me == 0) {
                    const float gts[4] = {inv, e1 * inv, e2 * inv, e3 * inv};
#pragma unroll
                    for (int k = 0; k < 4; ++k) { const int lr = __hip_atomic_fetch_add(lcnt + te[k], 1, __ATOMIC_RELAXED, __HIP_MEMORY_SCOPE_WORKGROUP); rowe[4 * rl + k] = te[k]; rowr[4 * rl + k] = lr; F.gate[(size_t)row * 4 + k] = gts[k]; }
                }
            }
        }
        __syncthreads();
        if (tid < 32) { const int n = lcnt[tid]; lbase[tid] = n ? (int)__hip_atomic_fetch_add((unsigned*)(F.ctl + CW_CNT + 64 * tid), (unsigned)n, RLX_AGENT) : 0; }
        __syncthreads();
        if (tid < 256) { const int e = rowe[tid], rank = lbase[e] + rowr[tid], row = row0 + (tid >> 2);
            F.list[(size_t)e * LISTCAP + rank] = row; F.scl[(size_t)e * LISTCAP + rank] = rows_s[tid >> 2]; F.slot[(size_t)row * 4 + (tid & 3)] = ((unsigned)e << 16) | (unsigned)rank; }
    }
}

__device__ __forceinline__ int moe_setup(Frame& F, int NT) {
    LAS int* aux = (LAS int*)(F.lds + AUX_OFF);
    __syncthreads();
    if (F.tid < 32) aux[F.tid] = (int)__hip_atomic_load((unsigned*)(F.ctl + CW_CNT + 64 * F.tid), RLX_AGENT);
    __syncthreads();
    if (F.tid == 0) { int tp = 0; for (int e = 0; e < NE; ++e) { aux[32 + e] = tp; tp += (aux[e] + 255) >> 8; } aux[64] = tp; }
    __syncthreads();
    const int total = aux[64] * NT;
    if (F.tid < 64) { const long L = (long)F.tid * F.G + F.vcu; int e = -1, mt = 0, mg = 0, pn = 0;
        if (L < total) { mg = (int)(L / NT); pn = (int)(L % NT); e = 0; for (int q = 1; q < NE; ++q) if (aux[32 + q] <= mg) e = q; mt = mg - aux[32 + e]; }
        aux[128 + 4 * F.tid + 0] = e; aux[128 + 4 * F.tid + 1] = mt; aux[128 + 4 * F.tid + 2] = mg; aux[128 + 4 * F.tid + 3] = pn; }
    __syncthreads();
    int n = 0; for (int i = 0; i < 64; ++i) if (aux[128 + 4 * i] >= 0) n = i + 1;
    return __builtin_amdgcn_readfirstlane(n);
}

__device__ __forceinline__ void p8_final(Frame& F) {
    LAS float* cF = (LAS float*)F.lds; LAS int* aux = (LAS int*)(F.lds + AUX_OFF);
    __syncthreads();
    if (F.tid < 32) aux[F.tid] = (int)__hip_atomic_load((unsigned*)(F.ctl + CW_CNT + 64 * F.tid), RLX_AGENT);
    __syncthreads();
    if (F.tid == 0) { int tp = 0; for (int e = 0; e < NE; ++e) { aux[32 + e] = tp; tp += (aux[e] + 255) >> 8; } }
    for (int rb = F.vcu; rb < T / 64; rb += F.G) {
        const int row0 = 64 * rb, b = row0 / SEQ;
        __syncthreads();
        for (int i = F.tid; i < D; i += NTHREADS) cF[i] = modv(F, b, 5 * D + i) * F.g_ffn_post[i];
        __syncthreads();
        for (int j = 0; j < 8; ++j) {
            const int row = row0 + 8 * F.wave + j;
            const v4u sl = *(const v4u*)(F.slot + (size_t)row * 4); const f32x4 gt = *(const f32x4*)(F.gate + (size_t)row * 4);
            const unsigned sv[4] = {sl.x, sl.y, sl.z, sl.w};
            float f[16];
#pragma unroll
            for (int i = 0; i < 16; ++i) f[i] = 0.f;
#pragma unroll
            for (int k = 0; k < 4; ++k) { const int e = (int)(sv[k] >> 16), pos = 256 * aux[32 + e] + (int)(sv[k] & 0xffffu); const float gk = gt[k];
                const v4u* yr = (const v4u*)(F.Y + (size_t)pos * D) + F.lane;
#pragma unroll
                for (int q = 0; q < 2; ++q) { const v4u y = yr[64 * q];
                    f[8 * q + 0] += gk * bf_lo(y.x); f[8 * q + 1] += gk * bf_hi(y.x); f[8 * q + 2] += gk * bf_lo(y.y); f[8 * q + 3] += gk * bf_hi(y.y);
                    f[8 * q + 4] += gk * bf_lo(y.z); f[8 * q + 5] += gk * bf_hi(y.z); f[8 * q + 6] += gk * bf_lo(y.w); f[8 * q + 7] += gk * bf_hi(y.w); } }
            float ss = 0.f;
#pragma unroll
            for (int i = 0; i < 16; ++i) ss += f[i] * f[i];
            const float rs = rsqrtf(wave_sum(ss) * (1.0f / D) + EPS);
#pragma unroll
            for (int q = 0; q < 2; ++q)
#pragma unroll
                for (int hq = 0; hq < 2; ++hq) { const int col = 512 * q + 8 * F.lane + 4 * hq; const v2u xw = *(const v2u*)(F.X1 + (size_t)row * D + col); f32x4* op = (f32x4*)(F.out2 + (size_t)row * D + col); const f32x4 x1 = {bf_lo(xw.x), bf_hi(xw.x), bf_lo(xw.y), bf_hi(xw.y)}, cf = *(LAS const f32x4*)(cF + col);
                    f32x4 fv = {f[8 * q + 4 * hq], f[8 * q + 4 * hq + 1], f[8 * q + 4 * hq + 2], f[8 * q + 4 * hq + 3]};
                    *op = x1 + cf * (fv * rs); }
        }
    }
}

struct Args { const float* in[26]; float* out; float* out2; unsigned char* ws; int ph_lo, ph_hi; };
__global__ void __launch_bounds__(NTHREADS, 2) fwd_kernel(Args args) {
    extern __shared__ __attribute__((aligned(16))) unsigned char lds[];
    Frame F;
    F.lds = (LAS unsigned char*)lds;
    F.tid = threadIdx.x; F.lane = F.tid & 63; F.wave = __builtin_amdgcn_readfirstlane(F.tid >> 6);
    F.G = gridDim.x; { const int bx = blockIdx.x; F.vcu = (F.G % 8 == 0) ? (bx % 8) * (F.G / 8) + bx / 8 : bx; }
    unsigned char* ws = args.ws;
    F.ctl = (gu32*)(ws + WS_CTL); F.ws = ws;
    F.x = args.in[0]; F.c = args.in[1]; F.w_ada = args.in[2]; F.b_ada = args.in[3]; F.g_mix_pre = args.in[4]; F.g_mix_post = args.in[5]; F.w_in = args.in[6];
    F.conv_w = args.in[7]; F.conv_b = args.in[8]; F.gaw = args.in[9]; F.gab = args.in[10]; F.gxw = args.in[11]; F.gxb = args.in[12]; F.lam = args.in[13];
    F.pool_w = args.in[14]; F.pool_b = args.in[15]; F.pool_s = args.in[16]; F.w_out = args.in[17]; F.g_ffn_pre = args.in[18]; F.g_ffn_post = args.in[19];
    F.router_w = args.in[20]; F.router_b = args.in[21]; F.w1 = args.in[22]; F.b1 = args.in[23]; F.w2 = args.in[24]; F.b2 = args.in[25];
    F.out = args.out; F.out2 = args.out2;
    F.modp = (float*)(ws + WS_MODP); F.CT = (float*)(ws + WS_CT); F.gate = (float*)(ws + WS_GATE); F.GT = (bf16*)(ws + WS_GT); F.WIN = (bf16*)(ws + WS_WIN); F.WOUT = (bf16*)(ws + WS_WOUT);
    F.H = (bf16*)(ws + WS_H); F.U = (bf16*)(ws + WS_U); F.MIXIN = (bf16*)(ws + WS_MIXIN); F.MIX = (bf16*)(ws + WS_MIX); F.X1 = (bf16*)(ws + WS_X1); F.H2 = ws + WS_H2;
    F.W1T = ws + WS_W1; F.W2T = ws + WS_W2; F.ACT = ws + WS_ACT; F.Y = (bf16*)(ws + WS_Y); F.sW1 = (float*)(ws + WS_SW1); F.sW2 = (float*)(ws + WS_SW2); F.scl = (float*)(ws + WS_SCL); F.slot = (unsigned*)(ws + WS_SLOT); F.list = (int*)(ws + WS_LIST);
    for (int u = F.tid; u < (LDS_BYTES - LDSCTL_OFF) / 4; u += NTHREADS) ((LAS unsigned*)(F.lds + LDSCTL_OFF))[u] = 0u;
    __syncthreads();
    XcdBarrier bar; bar.bar = (unsigned*)(F.ctl + CW_BAR); bar.x = 0; bar.st = nullptr;
    if (N_LAUNCHES == 1) bar = xcd_barrier_post((unsigned*)(F.ctl + CW_BAR), (volatile LAS unsigned*)(F.lds + LDSCTL_OFF));
    const int lo = args.ph_lo, hi = args.ph_hi;
#ifndef PH_MASK
#define PH_MASK 0x1ff
#endif
#define IN(k) (((PH_MASK >> (k)) & 1) && lo <= (k) && (k) < hi)
#define SEAM(k) do { if (IN(k) && IN((k) + 1)) xcd_barrier(bar); } while (0)

#ifdef PROBE_EXP
    if (lo >= 100) { return; }
#endif
    if (IN(0)) { p0_prologue(F); SEAM(0); }
    if (IN(1)) { p1_prenorm(F); SEAM(1); }
    if (IN(2)) {
        pg8::StaticSched S; S.init(F.WIN, T, INW, D, F.G, (int)blockIdx.x);
        pg8::EpiBf16 E{F.U, INW, nullptr, 0};
        pg8::gemm_phase<pg8::EpiBf16, pg8::StaticSched>(F.lds, (const char*)F.H, D, S, E);
        if (F.G == 256 && blockIdx.x >= 128) { __syncthreads(); f32x4 sva[16]; p0_strips<0, false>(F, NS_P0 + ((int)blockIdx.x - 128), 128, NSTRIPS_ALL, sva); }
        else if (F.G != 256 && blockIdx.x == 0) { __syncthreads(); f32x4 sva[16]; p0_strips<0, false>(F, NS_P0, 1, NSTRIPS_ALL, sva); }
        SEAM(2);
    }
    if (IN(3)) { p3_mixer(F); SEAM(3); }
    if (IN(4)) {
        pg8::StaticSched S; S.init(F.WOUT, T, D, D, F.G, (int)blockIdx.x);
        pg8::EpiBf16 E{F.MIX, D, nullptr, 0};
        pg8::gemm_phase<pg8::EpiBf16, pg8::StaticSched>(F.lds, (const char*)F.MIXIN, D, S, E);
        SEAM(4);
    }
    if (IN(5)) { p5_rows(F); SEAM(5); }
    if (IN(6)) {
        const int nu = moe_setup(F, 8);
        LAS const int* aux = (LAS const int*)(F.lds + AUX_OFF);
        pg8::MoeSched<true> S{(const char*)F.W1T, (size_t)DE2 * 1024, aux + 128, aux, F.list, nu};
        pg8::EpiSwiglu8 E{F.ACT, F.b1, F.sW1, F.scl, aux};
        pg8::gemm_phase<pg8::EpiSwiglu8, pg8::MoeSched<true>>(F.lds, (const char*)F.H2, 512, S, E);
        SEAM(6);
    }
    if (IN(7)) {
        const int nu = moe_setup(F, 4);
        LAS const int* aux = (LAS const int*)(F.lds + AUX_OFF);
        pg8::MoeSched<false> S{(const char*)F.W2T, (size_t)D * 1024, aux + 128, aux, F.list, nu};
        pg8::EpiY8 E{F.Y, F.b2, F.sW2};
        pg8::gemm_phase<pg8::EpiY8, pg8::MoeSched<false>>(F.lds, (const char*)F.ACT, 512, S, E);
        SEAM(7);
    }
    if (IN(8)) { p8_final(F); }
#undef IN
#undef SEAM
}

extern "C" void kernel_launch(void* const* d_in, const int* in_sizes, int n_in, void* d_out, int out_size, void* d_ws, size_t ws_size, hipStream_t stream) {
    static int grid = 0;
    if (grid == 0) {
        if (n_in != 26 || out_size != T * D || ws_size < WS_END) { fprintf(stderr, "kernel_launch: unexpected shapes (n_in %d, out %d, ws %zu); nothing launched\n", n_in, out_size, ws_size); grid = -1; return; }
        int dev = 0, cus = 0, per_cu = 0;
        if (hipGetDevice(&dev) != hipSuccess || hipDeviceGetAttribute(&cus, hipDeviceAttributeMultiprocessorCount, dev) != hipSuccess) { grid = -1; return; }
        if (hipFuncSetAttribute((const void*)fwd_kernel, hipFuncAttributeMaxDynamicSharedMemorySize, LDS_BYTES) != hipSuccess) { fprintf(stderr, "kernel_launch: hipFuncSetAttribute failed\n"); grid = -1; return; }
        if (hipOccupancyMaxActiveBlocksPerMultiprocessor(&per_cu, (const void*)fwd_kernel, NTHREADS, LDS_BYTES) != hipSuccess || per_cu < 1) { fprintf(stderr, "kernel_launch: occupancy query says %d blocks per CU\n", per_cu); (void)hipGetLastError(); grid = -1; return; }
        grid = cus;
        if (grid > 256) grid = 256;
    }
    if (grid < 0) return;
    (void)hipMemsetAsync((char*)d_ws + WS_CTL, 0, CTL_ZERO_BYTES, stream);
    Args a{};
    for (int i = 0; i < 26; ++i) a.in[i] = (const float*)d_in[i];
    a.out = (float*)d_out; a.out2 = (float*)d_out; a.ws = (unsigned char*)d_ws;
#ifdef PROBE_EXP
    { a.ph_lo = PROBE_EXP; a.ph_hi = PROBE_EXP + 1; hipLaunchKernelGGL(fwd_kernel, dim3(grid), dim3(NTHREADS), LDS_BYTES, stream, a); }
#endif
    for (int li = 0; li < N_LAUNCHES; ++li) {
        a.ph_lo = (N_LAUNCHES == 1) ? 0 : li; a.ph_hi = (N_LAUNCHES == 1) ? N_PHASES : li + 1;
#ifdef PROBE_DUP
        if (N_LAUNCHES > 1 && li == 8 && ((PROBE_DUP >> li) & 1)) { a.out2 = (float*)((char*)d_ws + WS_END); hipLaunchKernelGGL(fwd_kernel, dim3(grid), dim3(NTHREADS), LDS_BYTES, stream, a); a.out2 = (float*)d_out; hipLaunchKernelGGL(fwd_kernel, dim3(grid), dim3(NTHREADS), LDS_BYTES, stream, a); continue; }
#endif
        hipLaunchKernelGGL(fwd_kernel, dim3(grid), dim3(NTHREADS), LDS_BYTES, stream, a);
#ifdef PROBE_DUP
        if (N_LAUNCHES > 1 && ((PROBE_DUP >> li) & 1)) {
            if (li == 5) (void)hipMemsetAsync((char*)d_ws + WS_CTL, 0, CTL_ZERO_BYTES, stream);
            hipLaunchKernelGGL(fwd_kernel, dim3(grid), dim3(NTHREADS), LDS_BYTES, stream, a);
        }
#endif
    }
}
```

```cpp
#include <hip/hip_runtime.h>
#include <cstdio>
#include <cstdint>

#ifndef MK_N_LAUNCHES
#define MK_N_LAUNCHES 1
#endif

#define GAS __attribute__((address_space(1)))
#define LAS __attribute__((address_space(3)))
typedef unsigned short bf16;
typedef unsigned v4u __attribute__((ext_vector_type(4)));
typedef unsigned v2u __attribute__((ext_vector_type(2)));
typedef float f32x2 __attribute__((ext_vector_type(2)));
typedef float f32x4 __attribute__((ext_vector_type(4)));
typedef float f32x16 __attribute__((ext_vector_type(16)));
typedef short bf16x8 __attribute__((ext_vector_type(8)));
typedef __bf16 bf16v2 __attribute__((ext_vector_type(2)));
typedef int v4i __attribute__((ext_vector_type(4)));
typedef int v8i __attribute__((ext_vector_type(8)));
typedef GAS unsigned gu32;

constexpr int NB = 4, SEQ = 4096, D = 1024, T = NB * SEQ;
constexpr int LRU = 512, INW = 1536, NE = 32, DE2 = 2048, LISTCAP = 16384;
constexpr float EPS = 1e-6f;
constexpr int NWAVES = 8, NTHREADS = 512;
constexpr int N_PHASES = 9;
constexpr int NSTRIPS_ALL = 3072, NS_TAIL_PER = 4, NS_P0 = NSTRIPS_ALL - 128 * NS_TAIL_PER;
constexpr int N_LAUNCHES = MK_N_LAUNCHES;
static_assert(N_LAUNCHES == 1 || N_LAUNCHES == N_PHASES, "MK_N_LAUNCHES is 1 or 9");
constexpr float LOG2E = 1.4426950408889634f;

constexpr size_t MiB = 1u << 20;
constexpr size_t WS_CTL = 0, CTL_ZERO_BYTES = 65536;
constexpr size_t WS_MODP = 1 * MiB;
constexpr size_t WS_CT = 1 * MiB + 512 * 1024;
constexpr size_t WS_GT = 2 * MiB;
constexpr size_t WS_SW1 = 3 * MiB + 256 * 1024;
constexpr size_t WS_SW2 = 3 * MiB + 512 * 1024;
constexpr size_t WS_SCL = 14 * MiB;
constexpr size_t WS_WIN = 4 * MiB;
constexpr size_t WS_WOUT = 8 * MiB;
constexpr size_t WS_SLOT = 10 * MiB;
constexpr size_t WS_GATE = 11 * MiB;
constexpr size_t WS_LIST = 12 * MiB;
constexpr size_t WS_H = 16 * MiB;
constexpr size_t WS_U = 48 * MiB;
constexpr size_t WS_MIXIN = 96 * MiB;
constexpr size_t WS_MIX = 128 * MiB;
constexpr size_t WS_X1 = WS_MIXIN;
constexpr size_t WS_H2 = 160 * MiB;
constexpr size_t WS_W1 = 192 * MiB;
constexpr size_t WS_W2 = 320 * MiB;
constexpr size_t WS_ACT = 384 * MiB;
constexpr size_t WS_Y = 528 * MiB;
constexpr size_t WS_END = 672 * MiB;
constexpr int CW_TMO = 0, CW_BAR = 4096, CW_CNT = 8192;

constexpr int RING_BYTES = 131072;
constexpr int AUX_OFF = 131072;
constexpr int LDSCTL_OFF = 143360;
constexpr int LDS_BYTES = 147456;

#define RLX_AGENT __ATOMIC_RELAXED, __HIP_MEMORY_SCOPE_AGENT
#define LDS_WAIT() asm volatile("s_waitcnt lgkmcnt(0)" ::: "memory")
#define VM_WAIT() asm volatile("s_waitcnt vmcnt(0)" ::: "memory")

__device__ __forceinline__ unsigned pk2(float lo, float hi) { bf16v2 v; v.x = (__bf16)lo; v.y = (__bf16)hi; return __builtin_bit_cast(unsigned, v); }
__device__ __forceinline__ unsigned pk4_fp8(float a, float b, float c, float d) {
    a = __builtin_amdgcn_fmed3f(a, -448.0f, 448.0f); b = __builtin_amdgcn_fmed3f(b, -448.0f, 448.0f); c = __builtin_amdgcn_fmed3f(c, -448.0f, 448.0f); d = __builtin_amdgcn_fmed3f(d, -448.0f, 448.0f);
    int w = 0; w = __builtin_amdgcn_cvt_pk_fp8_f32(a, b, w, false); w = __builtin_amdgcn_cvt_pk_fp8_f32(c, d, w, true); return (unsigned)w; }
__device__ __forceinline__ unsigned pk4_fp8_nosat(float a, float b, float c, float d) { int w = 0; w = __builtin_amdgcn_cvt_pk_fp8_f32(a, b, w, false); w = __builtin_amdgcn_cvt_pk_fp8_f32(c, d, w, true); return (unsigned)w; }
__device__ __forceinline__ float bf_lo(unsigned w) { return __uint_as_float(w << 16); }
__device__ __forceinline__ float bf_hi(unsigned w) { return __uint_as_float(w & 0xffff0000u); }
__device__ __forceinline__ float wave_sum(float v) {
#pragma unroll
    for (int o = 1; o < 64; o <<= 1) v += __shfl_xor(v, o);
    return v;
}
__device__ __forceinline__ float fast_sigmoid(float z) { return __builtin_amdgcn_rcpf(1.0f + __builtin_amdgcn_exp2f(-z * LOG2E)); }
__device__ __forceinline__ float gelu_tanh(float x) {
    const float u = 0.7978845608028654f * (x + 0.044715f * x * x * x);
    const float e = __builtin_amdgcn_exp2f(2.0f * LOG2E * u);
    return x - x * __builtin_amdgcn_rcpf(e + 1.0f);
}

#define XB_TMO      128
#define XB_XCNT(j)  (256  + 64 * (j))
#define XB_XSUB(j)  (1280 + 64 * (j))
#define XB_XGEN(j)  (2304 + 64 * (j))
#define XB_TOP      3328
#define XB_TOPGEN   3392
#define XCD_BAR_WORDS 3456
#define XB_SPIN_CAP (1u << 18)
__device__ __forceinline__ unsigned xb_ld(unsigned* p)              { return __hip_atomic_load(p, __ATOMIC_RELAXED, __HIP_MEMORY_SCOPE_AGENT); }
__device__ __forceinline__ unsigned xb_add(unsigned* p, unsigned v) { return __hip_atomic_fetch_add(p, v, __ATOMIC_RELAXED, __HIP_MEMORY_SCOPE_AGENT); }
__device__ __forceinline__ unsigned xb_xcc_id() { return (unsigned)__builtin_amdgcn_s_getreg((3 << 11) | 20) & 0xFu; }
#define XB_SPIN(cond, bar) do { unsigned _sp = 0; while (cond) { __builtin_amdgcn_s_sleep(1); \
    if ((++_sp & 255u) == 0u) { if (xb_ld(&(bar)[XB_TMO])) break; if (_sp > XB_SPIN_CAP) { atomicAdd(&(bar)[XB_TMO], 1u); break; } } } } while (0)
struct XcdBarrier { unsigned* bar; unsigned x; volatile LAS unsigned* st; };
__device__ __forceinline__ XcdBarrier xcd_barrier_post(unsigned* bar, volatile LAS unsigned* st) {
    XcdBarrier b; b.bar = bar; b.x = xb_xcc_id(); b.st = st;
    if (threadIdx.x == 0) (void)xb_add(&bar[XB_XCNT(b.x)], 1u);
    return b;
}
__device__ __forceinline__ void xcd_barrier_complete(unsigned* bar, unsigned x, unsigned& nloc, unsigned& nx) {
    const unsigned G = gridDim.x * gridDim.y * gridDim.z;
    unsigned sum, cnt, mine, sp = 0u;
    for (;;) {
        sum = 0u; cnt = 0u; mine = 0u;
#pragma unroll
        for (unsigned j = 0; j < 16; ++j) { const unsigned c = xb_ld(&bar[XB_XCNT(j)]); sum += c; cnt += (c > 0u) ? 1u : 0u; mine = (j == x) ? c : mine; }
        if (sum == G) break;
        __builtin_amdgcn_s_sleep(1);
        if ((++sp & 255u) == 0u) { if (xb_ld(&bar[XB_TMO])) break; if (sp > XB_SPIN_CAP) { atomicAdd(&bar[XB_TMO], 1u); break; } }
    }
    nloc = mine > 0u ? mine : 1u; nx = cnt > 0u ? cnt : 1u;
}
__device__ __forceinline__ void xcd_barrier(const XcdBarrier& b) {
    asm volatile("s_waitcnt vmcnt(0)" ::: "memory");
    __syncthreads();
    if (threadIdx.x == 0) {
        unsigned* bar = b.bar;
        __builtin_amdgcn_s_waitcnt(0);
        unsigned nloc = b.st[0], nx = b.st[1];
        if (nloc == 0u) { xcd_barrier_complete(bar, b.x, nloc, nx); b.st[0] = nloc; b.st[1] = nx; }
        const unsigned old = xb_add(&bar[XB_XSUB(b.x)], 1u);
        const unsigned gen = old / nloc;
        if (old + 1u == (gen + 1u) * nloc) {
            __builtin_amdgcn_fence(__ATOMIC_RELEASE, "agent");
            asm volatile("s_waitcnt vmcnt(0)" ::: "memory");
            const unsigned og = xb_add(&bar[XB_TOP], 1u);
            const unsigned tg = og / nx;
            if (og + 1u == (tg + 1u) * nx) xb_add(&bar[XB_TOPGEN], 1u);
            else XB_SPIN(xb_ld(&bar[XB_TOPGEN]) == tg, bar);
            __builtin_amdgcn_fence(__ATOMIC_ACQUIRE, "agent");
            xb_add(&bar[XB_XGEN(b.x)], 1u);
            asm volatile("s_waitcnt vmcnt(0)" ::: "memory");
        } else {
            XB_SPIN(xb_ld(&bar[XB_XGEN(b.x)]) == gen, bar);
            __builtin_amdgcn_fence(__ATOMIC_ACQUIRE, "agent");
            asm volatile("s_waitcnt vmcnt(0)" ::: "memory");
        }
    }
    __syncthreads();
}

namespace pg8 {
constexpr int BM = 256, BK = 64, HALF = 128, HTB = HALF * BK * 2, STAGE_BYTES = 8 * HTB, NXCD = 8, WGM = 8;
__device__ __forceinline__ int lds_byte(int r, int c) { const int st = (r >> 4) * 2 + (c >> 5), rr = r & 15, cc = c & 31, ob = rr * 64 + cc * 2; return st * 1024 + (ob ^ (((ob >> 9) & 1) << 5)); }
__device__ __forceinline__ void stage_rc(int b, int& R, int& C) { const int st = b / 1024, sb = b % 1024, swz = sb ^ (((sb >> 9) & 1) << 5); R = (st >> 1) * 16 + swz / 64; C = (st & 1) * 32 + (swz % 64) / 2; }
__device__ __forceinline__ int perm32(int rho) { const int n = rho >> 4, i = rho & 15; return 8 * (i >> 2) + 4 * n + (i & 3); }

struct Unit { int row0, col0, e, mt; };

struct StaticSched {
    const char* Bt; int K, nM, nN, nwg, G, c;
    __device__ __forceinline__ void init(const void* Bt_, int M, int N, int K_, int G_, int c_) { Bt = (const char*)Bt_; K = K_; nM = M / BM; nN = N / BM; nwg = nM * nN; G = G_; c = c_; }
    __device__ __forceinline__ bool next(int i, Unit& u) const {
        const long L = (long)i * G + c; if (L >= nwg) return false;
        int wgid = (int)L; { const int q = nwg / NXCD, r = nwg % NXCD, xcd = wgid % NXCD, off = wgid / NXCD; wgid = (xcd < r ? xcd * (q + 1) : r * (q + 1) + (xcd - r) * q) + off; }
        const int nig = WGM * nN, gid = wgid / nig, fm = gid * WGM, gsz = (nM - fm) < WGM ? (nM - fm) : WGM;
        u.row0 = BM * (fm + ((wgid % nig) % gsz)); u.col0 = BM * ((wgid % nig) / gsz); u.e = 0; u.mt = 0; return true;
    }
    __device__ __forceinline__ const char* b_base(const Unit& u) const { return Bt + (size_t)u.col0 * K * 2; }
    __device__ __forceinline__ void a_off(const Unit& u, const int (&R)[2], const int (&C)[2], unsigned (&off)[2][2]) const {
#pragma unroll
        for (int h = 0; h < 2; ++h)
#pragma unroll
            for (int i = 0; i < 2; ++i) off[h][i] = (unsigned)((u.row0 + HALF * h + R[i]) * K + C[i]) * 2u;
    }
};
template <bool GATHER> struct MoeSched {
    const char* Bt; size_t estride; LAS const int* tab; LAS const int* cnt; const int* list; int nunits;
    __device__ __forceinline__ bool next(int i, Unit& u) const {
        if (i >= nunits) return false;
        u.e = __builtin_amdgcn_readfirstlane(tab[4 * i + 0]); u.mt = __builtin_amdgcn_readfirstlane(tab[4 * i + 1]);
        u.row0 = BM * __builtin_amdgcn_readfirstlane(tab[4 * i + 2]); u.col0 = BM * __builtin_amdgcn_readfirstlane(tab[4 * i + 3]); return true;
    }
    __device__ __forceinline__ const char* b_base(const Unit& u) const { return Bt + (size_t)u.e * estride + (size_t)u.col0 * 1024; }
    __device__ __forceinline__ void a_off(const Unit& u, const int (&R)[2], const int (&C)[2], unsigned (&off)[2][2]) const {
        if constexpr (GATHER) {
            const int n = cnt[u.e]; const int* lp = list + (size_t)u.e * LISTCAP;
#pragma unroll
            for (int h = 0; h < 2; ++h)
#pragma unroll
                for (int i = 0; i < 2; ++i) { int r = BM * u.mt + HALF * h + R[i]; r = r < n ? r : n - 1; const int tok = lp[r]; off[h][i] = (unsigned)(tok * 512 + C[i]) * 2u; }
        } else {
#pragma unroll
            for (int h = 0; h < 2; ++h)
#pragma unroll
                for (int i = 0; i < 2; ++i) off[h][i] = (unsigned)((u.row0 + HALF * h + R[i]) * 512 + C[i]) * 2u;
        }
    }
};

struct EpiBf16 {
    static constexpr bool PERM = true, F8 = false;
    bf16* O; int ldc; const float* bias; int bias_estride;
    __device__ __forceinline__ void operator()(const f32x4 (&acc)[2][2][4][2], const Unit& u, int wr, int wc, int fr, int fq) const {
        const int row0 = u.row0 + wr * 64 + fr, col0 = u.col0 + wc * 32 + 8 * fq;
        f32x4 bv[2][2];
#pragma unroll
        for (int bj = 0; bj < 2; ++bj)
#pragma unroll
            for (int n = 0; n < 2; ++n) bv[bj][n] = bias ? *(const f32x4*)(bias + (size_t)u.e * bias_estride + col0 + bj * HALF + 4 * n) : (f32x4){0.f, 0.f, 0.f, 0.f};
#pragma unroll
        for (int ai = 0; ai < 2; ++ai)
#pragma unroll
            for (int m = 0; m < 4; ++m) { bf16* rowp = O + (size_t)(row0 + ai * HALF + m * 16) * ldc + col0;
#pragma unroll
                for (int bj = 0; bj < 2; ++bj) { const f32x4 v0 = acc[ai][bj][m][0] + bv[bj][0], v1 = acc[ai][bj][m][1] + bv[bj][1];
                    v4u w; w.x = pk2(v0[0], v0[1]); w.y = pk2(v0[2], v0[3]); w.z = pk2(v1[0], v1[1]); w.w = pk2(v1[2], v1[3]);
                    *(v4u*)(rowp + bj * HALF) = w; } }
    }
};
struct EpiSwiglu8 {
    static constexpr bool PERM = false, F8 = true;
    unsigned char* O; const float* b1; const float* sW; const float* scl; LAS const int* cnt;
    __device__ __forceinline__ void operator()(const f32x4 (&acc)[2][2][4][2], const Unit& u, int wr, int wc, int fr, int fq) const {
        const int row0 = u.row0 + wr * 64 + fr, rank0 = BM * u.mt + wr * 64 + fr, n = cnt[u.e];
        const int j0 = (u.col0 >> 1) + 16 * wc + 4 * fq;
        f32x2 bg[2][2], bl[2][2]; float sg[2];
#pragma unroll
        for (int bj = 0; bj < 2; ++bj) { const float* bp = b1 + (size_t)u.e * DE2 + 2 * (j0 + 64 * bj); const f32x4 p = *(const f32x4*)bp, q = *(const f32x4*)(bp + 4);
            bg[bj][0] = (f32x2){p[0], p[2]}; bg[bj][1] = (f32x2){q[0], q[2]}; bl[bj][0] = (f32x2){p[1], p[3]}; bl[bj][1] = (f32x2){q[1], q[3]};
            sg[bj] = sW[u.e * 64 + ((u.col0 + 128 * bj) >> 5) + wc]; }
        float sa[2][4];
#pragma unroll
        for (int ai = 0; ai < 2; ++ai)
#pragma unroll
            for (int m = 0; m < 4; ++m) { const int rk = rank0 + ai * HALF + m * 16; sa[ai][m] = rk < n ? scl[(size_t)u.e * LISTCAP + rk] : 0.f; }
#pragma unroll
        for (int ai = 0; ai < 2; ++ai)
#pragma unroll
            for (int m = 0; m < 4; ++m) { unsigned char* rowp = O + (size_t)(row0 + ai * HALF + m * 16) * 1024 + j0;
#pragma unroll
                for (int bj = 0; bj < 2; ++bj) { const float sc = sa[ai][m] * sg[bj]; float o[4];
#pragma unroll
                    for (int hx = 0; hx < 2; ++hx) {
                        const f32x2 ga = {acc[ai][bj][m][0][2 * hx], acc[ai][bj][m][0][2 * hx + 1]}, la = {acc[ai][bj][m][1][2 * hx], acc[ai][bj][m][1][2 * hx + 1]};
                        f32x2 g = ga * sc + bg[bj][hx], l = la * sc + bl[bj][hx];
                        g.x = fminf(g.x, 7.0f); g.y = fminf(g.y, 7.0f); l.x = __builtin_amdgcn_fmed3f(l.x, -7.0f, 7.0f); l.y = __builtin_amdgcn_fmed3f(l.y, -7.0f, 7.0f);
                        const f32x2 z = g * (-1.702f * LOG2E); f32x2 e; e.x = __builtin_amdgcn_exp2f(z.x); e.y = __builtin_amdgcn_exp2f(z.y);
                        const f32x2 d = e + 1.0f; f32x2 r; r.x = __builtin_amdgcn_rcpf(d.x); r.y = __builtin_amdgcn_rcpf(d.y);
                        const f32x2 ov = (g * r) * (l * 8.0f + 8.0f);
                        o[2 * hx] = ov.x; o[2 * hx + 1] = ov.y; }
                    *(unsigned*)(rowp + bj * 64) = pk4_fp8_nosat(o[0], o[1], o[2], o[3]); } }
    }
};
struct EpiY8 {
    static constexpr bool PERM = true, F8 = true;
    bf16* O; const float* bias; const float* sW;
    __device__ __forceinline__ void operator()(const f32x4 (&acc)[2][2][4][2], const Unit& u, int wr, int wc, int fr, int fq) const {
        const int row0 = u.row0 + wr * 64 + fr, col0 = u.col0 + wc * 32 + 8 * fq;
        f32x4 bv[2][2], sv[2][2];
#pragma unroll
        for (int bj = 0; bj < 2; ++bj)
#pragma unroll
            for (int n = 0; n < 2; ++n) { bv[bj][n] = *(const f32x4*)(bias + (size_t)u.e * D + col0 + bj * HALF + 4 * n); const float s1 = sW[u.e * 32 + ((u.col0 + 128 * bj) >> 5) + wc] * 0.125f; sv[bj][n] = (f32x4){s1, s1, s1, s1}; }
#pragma unroll
        for (int ai = 0; ai < 2; ++ai)
#pragma unroll
            for (int m = 0; m < 4; ++m) { bf16* rowp = O + (size_t)(row0 + ai * HALF + m * 16) * D + col0;
#pragma unroll
                for (int bj = 0; bj < 2; ++bj) { const f32x4 v0 = acc[ai][bj][m][0] * sv[bj][0] + bv[bj][0], v1 = acc[ai][bj][m][1] * sv[bj][1] + bv[bj][1];
                    v4u w; w.x = pk2(v0[0], v0[1]); w.y = pk2(v0[2], v0[3]); w.z = pk2(v1[0], v1[1]); w.w = pk2(v1[2], v1[3]);
                    *(v4u*)(rowp + bj * HALF) = w; } }
    }
};

template <class Epi, class Sched>
__device__ __forceinline__ void gemm_phase(LAS unsigned char* lds, const char* Abase, const int K, const Sched& S, const Epi& E) {
    const int tid = threadIdx.x, wid = __builtin_amdgcn_readfirstlane(tid >> 6), lane = tid & 63, wr = wid >> 2, wc = wid & 3, fr = lane & 15, fq = lane >> 4;
    const int nt = K / BK;
    int R[2], C[2]; unsigned voffB[2];
#pragma unroll
    for (int i = 0; i < 2; ++i) { stage_rc(tid * 16 + i * 8192, R[i], C[i]); const int Rb = Epi::PERM ? ((R[i] & ~31) + perm32(R[i] & 31)) : R[i]; voffB[i] = (unsigned)(Rb * K + C[i]) * 2u; }
    const size_t kstep = (size_t)(BK * 2);
    const size_t hstep = (size_t)HALF * K * 2;
    const unsigned ldsw = (unsigned)wid * 1024u;
    const int aoff = lds_byte(wr * 64 + fr, fq * 8), boff = lds_byte(wc * 32 + fr, fq * 8);
#define PG8_SA(b, h) (((b) * 2 + (h)) * HTB)
#define PG8_SB(b, h) ((4 + (b) * 2 + (h)) * HTB)
#define PG8_STAGEB(bufoff, gbase) do { _Pragma("unroll") for (int _i = 0; _i < 2; ++_i) \
        __builtin_amdgcn_global_load_lds((const unsigned*)((const char*)(gbase) + voffB[_i]), (LAS unsigned*)(lds + (bufoff) + ldsw + _i * 8192), 16, 0, 0); } while (0)
#define PG8_STAGEA(bufoff, o, h, kb) do { _Pragma("unroll") for (int _i = 0; _i < 2; ++_i) \
        __builtin_amdgcn_global_load_lds((const unsigned*)(Abase + (size_t)(o)[h][_i] + (size_t)(kb)), (LAS unsigned*)(lds + (bufoff) + ldsw + _i * 8192), 16, 0, 0); } while (0)
#define PG8_LDA(dst, b, h) do { _Pragma("unroll") for (int m = 0; m < 4; ++m) _Pragma("unroll") for (int k = 0; k < 2; ++k) dst[m][k] = *(const LAS bf16x8*)(lds + PG8_SA(b, h) + aoff + m * 2048 + k * 1024); } while (0)
#define PG8_LDB(dst, b, h) do { _Pragma("unroll") for (int n = 0; n < 2; ++n) _Pragma("unroll") for (int k = 0; k < 2; ++k) dst[n][k] = *(const LAS bf16x8*)(lds + PG8_SB(b, h) + boff + n * 2048 + k * 1024); } while (0)
#define PG8_CAT(f) __builtin_shufflevector(__builtin_bit_cast(v4i, (f)[0]), __builtin_bit_cast(v4i, (f)[1]), 0, 1, 2, 3, 4, 5, 6, 7)
#define PG8_MMA(ai, bj, At, Bt) do { __builtin_amdgcn_s_setprio(1); _Pragma("unroll") for (int m = 0; m < 4; ++m) _Pragma("unroll") for (int n = 0; n < 2; ++n) { \
        if constexpr (Epi::F8) { const v8i _b = PG8_CAT(Bt[n]), _a = PG8_CAT(At[m]); asm volatile("v_mfma_scale_f32_16x16x128_f8f6f4 %0, %1, %2, %0, %3, %3 op_sel_hi:[0,0,0]" : "+v"(acc[ai][bj][m][n]) : "v"(_b), "v"(_a), "v"(one8)); } \
        else { _Pragma("unroll") for (int k = 0; k < 2; ++k) acc[ai][bj][m][n] = __builtin_amdgcn_mfma_f32_16x16x32_bf16(Bt[n][k], At[m][k], acc[ai][bj][m][n], 0, 0, 0); } } __builtin_amdgcn_s_setprio(0); } while (0)
#define PG8_WAIT_V(n) asm volatile("s_waitcnt vmcnt(" #n ")" ::: "memory")
#define PG8_WAIT_L(n) asm volatile("s_waitcnt lgkmcnt(" #n ")" ::: "memory")
#define PG8_BAR __builtin_amdgcn_s_barrier()
#define PG8_SCHED __builtin_amdgcn_sched_barrier(0)
    Unit cur, nxt; int ui = 0;
    if (!S.next(0, cur)) return;
    int one8 = 0x7f7f7f7f; asm volatile("" : "+v"(one8));
    f32x4 acc[2][2][4][2];
#pragma unroll
    for (int a = 0; a < 2; ++a)
#pragma unroll
        for (int b = 0; b < 2; ++b)
#pragma unroll
            for (int m = 0; m < 4; ++m)
#pragma unroll
                for (int n = 0; n < 2; ++n) acc[a][b][m][n] = (f32x4){0.f, 0.f, 0.f, 0.f};
    bf16x8 At[4][2], B0[2][2], B1[2][2];
    unsigned offA[2][2], offN[2][2];
    S.a_off(cur, R, C, offA);
    const char* cB = S.b_base(cur);
    PG8_STAGEB(PG8_SB(0, 0), cB); PG8_STAGEB(PG8_SB(0, 1), cB + hstep); PG8_STAGEA(PG8_SA(0, 0), offA, 0, 0); PG8_STAGEA(PG8_SA(0, 1), offA, 1, 0);
    if (wr == 1) PG8_BAR;
    PG8_WAIT_V(2); PG8_BAR;
    PG8_STAGEB(PG8_SB(1, 0), cB + kstep); PG8_STAGEA(PG8_SA(1, 0), offA, 0, kstep); PG8_STAGEB(PG8_SB(1, 1), cB + hstep + kstep);
    PG8_WAIT_V(6); PG8_BAR;
    for (;;) {
        const bool has_next = S.next(ui + 1, nxt);
        const char* nB = has_next ? S.b_base(nxt) : cB;
        if (has_next) { S.a_off(nxt, R, C, offN); } else {
#pragma unroll
            for (int h = 0; h < 2; ++h)
#pragma unroll
                for (int i = 0; i < 2; ++i) offN[h][i] = offA[h][i]; }
        asm volatile("" : "+v"(offN[0][0]), "+v"(offN[0][1]), "+v"(offN[1][0]), "+v"(offN[1][1]));
#pragma unroll 1
        for (int t = 0; t < nt; t += 2) {
            const bool last = (t == nt - 2);
            const size_t k1 = (size_t)(t + 1) * kstep;
            const size_t k2 = last ? 0 : (size_t)(t + 2) * kstep, k3 = k2 + kstep;
            const char* b2 = last ? nB : cB + (size_t)(t + 2) * kstep; const char* b3 = b2 + kstep;
            unsigned o2[2][2];
#pragma unroll
            for (int h = 0; h < 2; ++h)
#pragma unroll
                for (int i = 0; i < 2; ++i) o2[h][i] = last ? offN[h][i] : offA[h][i];
            PG8_LDB(B0, 0, 0); PG8_LDB(B1, 0, 1); PG8_SCHED; PG8_LDA(At, 0, 0); PG8_STAGEA(PG8_SA(1, 1), offA, 1, k1);
            PG8_WAIT_V(8); PG8_WAIT_L(0); PG8_BAR; PG8_MMA(0, 0, At, B0); PG8_MMA(0, 1, At, B1); PG8_BAR; PG8_SCHED;
            PG8_LDA(At, 0, 1); PG8_STAGEB(PG8_SB(0, 0), b2); PG8_STAGEB(PG8_SB(0, 1), b2 + hstep); PG8_STAGEA(PG8_SA(0, 0), o2, 0, k2);
            PG8_WAIT_V(8); PG8_WAIT_L(0); PG8_BAR; PG8_MMA(1, 0, At, B0); PG8_MMA(1, 1, At, B1); PG8_BAR; PG8_SCHED;
            PG8_LDB(B0, 1, 0); PG8_LDB(B1, 1, 1); PG8_SCHED; PG8_LDA(At, 1, 0); PG8_STAGEA(PG8_SA(0, 1), o2, 1, k2);
            PG8_WAIT_V(8); PG8_WAIT_L(0); PG8_BAR; PG8_MMA(0, 0, At, B0); PG8_MMA(0, 1, At, B1); PG8_BAR; PG8_SCHED;
            PG8_LDA(At, 1, 1); PG8_STAGEB(PG8_SB(1, 0), b3); PG8_STAGEB(PG8_SB(1, 1), b3 + hstep); PG8_STAGEA(PG8_SA(1, 0), o2, 0, k3);
            PG8_WAIT_V(8); PG8_WAIT_L(0); PG8_BAR; PG8_MMA(1, 0, At, B0); PG8_MMA(1, 1, At, B1); PG8_BAR; PG8_SCHED;
        }
        if (wr == 0) PG8_BAR;
        if constexpr (Epi::F8) asm volatile("s_nop 15\n\ts_nop 7" ::: "memory");
        { int lz = lane; asm volatile("" : "+v"(lz));
          E(acc, cur, wr, wc, lz & 15, lz >> 4); }
        if (!has_next) break;
#pragma unroll
        for (int a = 0; a < 2; ++a)
#pragma unroll
            for (int b = 0; b < 2; ++b)
#pragma unroll
                for (int m = 0; m < 4; ++m)
#pragma unroll
                    for (int n = 0; n < 2; ++n) acc[a][b][m][n] = (f32x4){0.f, 0.f, 0.f, 0.f};
        cur = nxt; cB = nB; ++ui;
#pragma unroll
        for (int h = 0; h < 2; ++h)
#pragma unroll
            for (int i = 0; i < 2; ++i) offA[h][i] = offN[h][i];
        if (wr == 1) PG8_BAR;
    }
    PG8_WAIT_V(0);
    PG8_BAR;
#undef PG8_SA
#undef PG8_SB
#undef PG8_STAGEA
#undef PG8_STAGEB
#undef PG8_LDA
#undef PG8_LDB
#undef PG8_MMA
#undef PG8_CAT
#undef PG8_WAIT_V
#undef PG8_WAIT_L
#undef PG8_BAR
#undef PG8_SCHED
}
}

struct Frame {
    LAS unsigned char* lds;
    gu32* ctl; unsigned char* ws;
    int tid, lane, wave, vcu, G;
    const float *x, *c, *w_ada, *b_ada, *g_mix_pre, *g_mix_post, *w_in, *conv_w, *conv_b, *gaw, *gab, *gxw, *gxb, *lam, *pool_w, *pool_b, *pool_s, *w_out,
                *g_ffn_pre, *g_ffn_post, *router_w, *router_b, *w1, *b1, *w2, *b2;
    float* out; float* out2;
    float *modp, *CT, *gate, *sW1, *sW2, *scl; bf16 *GT, *WIN, *WOUT, *H, *U, *MIXIN, *MIX, *Y, *X1; unsigned char *H2, *W1T, *W2T, *ACT; unsigned* slot; int* list;
};
__device__ __forceinline__ float modv(const Frame& F, int b, int n) {
    const float* p = F.modp + b * 6144 + n;
    return ((p[0] + p[4 * 6144]) + (p[8 * 6144] + p[12 * 6144])) + F.b_ada[n];
}

struct TrJob { const float* W; bf16* WT; int ldn, nblk, K, mode; };
__device__ __forceinline__ void tr_load(const TrJob& j, int item, int lane, f32x4 (&v)[8]) {
    const int kb = item / j.nblk, nb = item % j.nblk; const float* p = j.W + (size_t)(64 * kb + (lane >> 3)) * j.ldn + 32 * nb + 4 * (lane & 7);
#pragma unroll
    for (int i = 0; i < 8; ++i) v[i] = *(const f32x4*)(p + (size_t)(8 * i) * j.ldn);
}
__device__ __forceinline__ void tr_put(LAS float* scr, int lane, const f32x4 (&v)[8]) {
#pragma unroll
    for (int i = 0; i < 8; ++i) { LAS float* s = scr + (8 * i + (lane >> 3)) * 33 + 4 * (lane & 7); s[0] = v[i][0]; s[1] = v[i][1]; s[2] = v[i][2]; s[3] = v[i][3]; }
}
__device__ __forceinline__ void tr_store(const TrJob& j, int item, int lane, LAS const float* scr) {
    const int kb = item / j.nblk, nb = item % j.nblk, k0 = 64 * kb, n0 = 32 * nb, c = lane & 7;
#pragma unroll
    for (int q = 0; q < 4; ++q) { const int n = (lane >> 3) + 8 * q; LAS const float* s = scr + (8 * c) * 33 + n;
        v4u o; o.x = pk2(s[0 * 33], s[1 * 33]); o.y = pk2(s[2 * 33], s[3 * 33]); o.z = pk2(s[4 * 33], s[5 * 33]); o.w = pk2(s[6 * 33], s[7 * 33]);
        const int orow = j.mode ? n0 + ((n & 1) ? 16 + (n >> 1) : (n >> 1)) : n0 + n;
        *(v4u*)(j.WT + (size_t)orow * j.K + k0 + 8 * c) = o; }
}
__device__ __forceinline__ bool tr_job(const Frame& F, int it, TrJob& j, int& item) {
    constexpr int I_IN = 16 * 32, I_OUT = 16 * 32;
    if (it < I_IN) { j = TrJob{F.w_in, F.WIN, INW, 32, D, 0}; item = it; return true; } it -= I_IN;
    if (it < I_OUT) { j = TrJob{F.w_out, F.WOUT, D, 32, D, 0}; item = it; return true; }
    return false;
}
__device__ __forceinline__ void strip_job(const Frame& F, int s, const float*& W, unsigned char*& WT, float*& SW, int& ldn, int& mode) {
    const bool is1 = s < 2048; const int s2 = is1 ? s : s - 2048; const int e = is1 ? (s2 >> 6) : (s2 >> 5), nb = is1 ? (s2 & 63) : (s2 & 31);
    const int rows = is1 ? DE2 : D;
    const size_t r0 = (size_t)e * rows + 32 * nb;
    const long d21 = F.w2 - F.w1;
    W = F.w1 + (is1 ? 0l : d21) + (size_t)e * D * rows + 32 * nb;
    WT = F.ws + (is1 ? WS_W1 : WS_W2) + r0 * 1024;
    SW = (float*)(F.ws + (is1 ? WS_SW1 : WS_SW2)) + (is1 ? e * 64 + nb : e * 32 + nb);
    ldn = rows; mode = is1 ? 1 : 0;
}
__device__ __forceinline__ void strip_load(const float* W, int ldn, int wave, int lane, f32x4 (&v)[16]) {
    const float* p = W + (size_t)(128 * wave + (lane >> 3)) * ldn + 4 * (lane & 7);
#pragma unroll
    for (int i = 0; i < 16; ++i) v[i] = *(const f32x4*)(p + (size_t)(8 * i) * ldn);
}
template <int PROBE, bool PRE> __device__ __forceinline__ void p0_strips(Frame& F, int first, int step, int last, f32x4 (&va)[16]) {
    const int lane = F.lane;
    {
        const int w = F.wave;
        LAS float* scr = (LAS float*)(F.lds + w * 16896);
        LAS float* pm = (LAS float*)(F.lds + 8 * 16896);
        const int NSTRIPS = last;
        f32x4 vb[16];
        int par = 0;
#define STRIP_ISSUE(v, sidx) do { if ((sidx) < NSTRIPS) { const float* _W; unsigned char* _WT; float* _SW; int _ldn, _mode; strip_job(F, (sidx), _W, _WT, _SW, _ldn, _mode); strip_load(_W, _ldn, w, lane, v); } } while (0)
#define STRIP_PROCESS(v, sidx, nextv, nextidx) do { \
            unsigned char* cWT; float* cSW; int cmode; { const float* _W; int _ldn; strip_job(F, (sidx), _W, cWT, cSW, _ldn, cmode); } \
            f32x4 mx = {0.f, 0.f, 0.f, 0.f}; \
            _Pragma("unroll") for (int i = 0; i < 16; ++i) { LAS float* sp = scr + (8 * i + (lane >> 3)) * 33 + 4 * (lane & 7); sp[0] = v[i][0]; sp[1] = v[i][1]; sp[2] = v[i][2]; sp[3] = v[i][3]; \
                mx[0] = fmaxf(mx[0], fabsf(v[i][0])); mx[1] = fmaxf(mx[1], fabsf(v[i][1])); mx[2] = fmaxf(mx[2], fabsf(v[i][2])); mx[3] = fmaxf(mx[3], fabsf(v[i][3])); } \
            _Pragma("unroll") for (int x = 0; x < 4; ++x) { float m = mx[x]; m = fmaxf(m, __shfl_xor(m, 8)); m = fmaxf(m, __shfl_xor(m, 16)); m = fmaxf(m, __shfl_xor(m, 32)); mx[x] = m; } \
            if (lane < 8) *(LAS f32x4*)(pm + (par * 8 + w) * 32 + 4 * lane) = mx; \
            STRIP_ISSUE(nextv, nextidx); \
            asm volatile("s_waitcnt lgkmcnt(0)" ::: "memory"); __builtin_amdgcn_s_barrier(); asm volatile("" ::: "memory"); \
            float inv[2]; \
            { const f32x4 p4 = *(LAS const f32x4*)(pm + par * 256 + 4 * lane); float am = fmaxf(fmaxf(p4[0], p4[1]), fmaxf(p4[2], p4[3])); \
              _Pragma("unroll") for (int o_ = 1; o_ < 64; o_ <<= 1) am = fmaxf(am, __shfl_xor(am, o_)); \
              const float sc = am > 0.f ? am * (1.0f / 448.0f) : 1.0f; inv[0] = 1.0f / sc; inv[1] = inv[0]; \
              if (w == 0 && lane == 0) cSW[0] = sc; } \
            _Pragma("unroll") for (int tl = 0; tl < 2; ++tl) _Pragma("unroll") for (int jj = 0; jj < 2; ++jj) { const int n = (lane >> 2) + 16 * jj, c = lane & 3; LAS const float* sp = scr + (64 * tl + 16 * c) * 33 + n; const float iv = inv[jj]; \
                    v4u o; \
                    o.x = pk4_fp8(sp[0 * 33] * iv, sp[1 * 33] * iv, sp[2 * 33] * iv, sp[3 * 33] * iv); o.y = pk4_fp8(sp[4 * 33] * iv, sp[5 * 33] * iv, sp[6 * 33] * iv, sp[7 * 33] * iv); \
                    o.z = pk4_fp8(sp[8 * 33] * iv, sp[9 * 33] * iv, sp[10 * 33] * iv, sp[11 * 33] * iv); o.w = pk4_fp8(sp[12 * 33] * iv, sp[13 * 33] * iv, sp[14 * 33] * iv, sp[15 * 33] * iv); \
                    const int orow = cmode ? ((n & 1) ? 16 + (n >> 1) : (n >> 1)) : n; \
                    if (PROBE != 2) *(v4u*)(cWT + (PROBE ? (size_t)WS_END : (size_t)0) + (size_t)orow * 1024 + 128 * w + 64 * tl + 16 * c) = o; else if (o.x == 0x12345678u) *(v4u*)(cWT) = o; } \
            asm volatile("s_waitcnt lgkmcnt(0)" ::: "memory"); par ^= 1; } while (0)
        int st = first;
        if (!PRE) STRIP_ISSUE(va, st);
        STRIP_ISSUE(vb, st + step);
        while (st < NSTRIPS) {
            STRIP_PROCESS(va, st, va, st + 2 * step); st += step;
            if (st >= NSTRIPS) break;
            STRIP_PROCESS(vb, st, vb, st + 2 * step); st += step;
        }
#undef STRIP_ISSUE
#undef STRIP_PROCESS
    }
}
__device__ __forceinline__ void p0_prologue(Frame& F) {
    const int tid = F.tid, lane = F.lane;
    if (F.G == 256) {
        const int it = blockIdx.x, kq = it >> 6, nc = it & 63;
        const float ca0 = F.c[(tid >> 8) * D + 256 * kq + (tid & 255)], ca1 = F.c[((tid + 512) >> 8) * D + 256 * kq + (tid & 255)];
        const int c4 = tid % 24, kl = tid / 24;
        f32x4 wv[16];
        { const float* wp = F.w_ada + (size_t)(256 * kq + (tid < 384 ? kl : 0)) * 6144 + 96 * nc + 4 * (tid < 384 ? c4 : 0);
#pragma unroll
          for (int j = 0; j < 16; ++j) wv[j] = *(const f32x4*)(wp + (size_t)(16 * j) * 6144); }
        float wb[4];
#pragma unroll
        for (int j = 0; j < 4; ++j) { const int i = tid + 512 * j; wb[j] = F.w_in[(size_t)(4 * it + (i >> 9)) * INW + 1024 + (i & 511)]; }
        const int gw = F.vcu * NWAVES + F.wave; TrJob tj; int titem = 0; f32x4 dv[8];
        const bool hasD = tr_job(F, gw < 1024 ? gw : 0, tj, titem) && gw < 1024;
        tr_load(tj, titem, lane, dv);
        const int gt = blockIdx.x * NTHREADS + tid; const bool hasG = gt < 64 * 17 * 64;
        const int gl = gt & 63, gs = (gt >> 6) % 17, gun = hasG ? gt / (64 * 17) : 0, gh = gun >> 3, go = gun & 7, gm = gl & 31, gk0 = 8 * (gl >> 5);
        float cwv[8], gvv[8];
#pragma unroll
        for (int jj = 0; jj < 8; ++jj) { const int i = 16 * (gs & 3) + gk0 + jj, tap = (gs < 16) ? (gs >> 2) : 0; cwv[jj] = F.conv_w[tap * LRU + 64 * gh + i];
            const float* gp = (gm < 8 ? F.gaw : F.gxw) + (size_t)(gh * 64 + i) * 64 + 8 * go + (gm & 7); gvv[jj] = *gp; }
        const int cch = blockIdx.x * NWAVES + F.wave; const bool hasC = cch < LRU; const int chh = hasC ? (cch >> 6) : 0, cjn = cch & 63;
        const float ccb = F.conv_b[64 * chh + lane], cga = F.gaw[(size_t)(chh * 64 + lane) * 64 + cjn], cgx = F.gxw[(size_t)(chh * 64 + lane) * 64 + cjn];
        f32x4 sva[16];
        if (F.vcu < NS_P0) { const float* sW_; unsigned char* sWT_; float* sSW_; int sldn_, smode_; strip_job(F, F.vcu, sW_, sWT_, sSW_, sldn_, smode_); strip_load(sW_, sldn_, F.wave, lane, sva); }
        LAS float* cact = (LAS float*)F.lds; LAS float* red = (LAS float*)(F.lds + 4096);
        cact[tid] = ca0 / (1.0f + __expf(-ca0)); cact[tid + 512] = ca1 / (1.0f + __expf(-ca1));
        __syncthreads();
        if (tid < 384) {
            f32x4 a0 = {0.f, 0.f, 0.f, 0.f}, a1 = a0, a2 = a0, a3 = a0;
#pragma unroll
            for (int j = 0; j < 16; ++j) { const int k = kl + 16 * j; a0 += cact[k] * wv[j]; a1 += cact[256 + k] * wv[j]; a2 += cact[512 + k] * wv[j]; a3 += cact[768 + k] * wv[j]; }
            *(LAS f32x4*)(red + (kl * 4 + 0) * 96 + 4 * c4) = a0; *(LAS f32x4*)(red + (kl * 4 + 1) * 96 + 4 * c4) = a1;
            *(LAS f32x4*)(red + (kl * 4 + 2) * 96 + 4 * c4) = a2; *(LAS f32x4*)(red + (kl * 4 + 3) * 96 + 4 * c4) = a3;
        }
        __syncthreads();
        if (tid < 384) { const int b = tid / 96, col = tid % 96; float sm = 0.f;
#pragma unroll
            for (int k2 = 0; k2 < 16; ++k2) sm += red[(k2 * 4 + b) * 96 + col];
            F.modp[(kq * 4 + b) * 6144 + 96 * nc + col] = sm; }
        __syncthreads();
        { LAS float* win = (LAS float*)F.lds;
#pragma unroll
          for (int j = 0; j < 4; ++j) win[tid + 512 * j] = wb[j];
          __syncthreads();
          const int g = tid >> 7, d = tid & 127; float a0 = 0.f, a1 = 0.f, a2 = 0.f, a3 = 0.f;
          const float* pw = F.pool_w + (size_t)g * 128 * 128 + d; LAS const float* wl = win + 128 * g;
#pragma unroll 16
          for (int cc = 0; cc < 128; ++cc) { const float p = pw[cc * 128]; a0 += wl[cc] * p; a1 += wl[512 + cc] * p; a2 += wl[1024 + cc] * p; a3 += wl[1536 + cc] * p; }
          v2u o; o.x = pk2(a0, a1); o.y = pk2(a2, a3);
          *(v2u*)(F.WIN + (size_t)(1024 + tid) * D + 4 * it) = o;
          __syncthreads(); }
        if (hasG) { float v[8];
#pragma unroll
            for (int jj = 0; jj < 8; ++jj) { const int kk = gk0 + jj; float val = 0.f;
                if (gs < 16) { const int i = 16 * (gs & 3) + kk; if (gm < 16) val = cwv[jj] * gvv[jj]; else if (gm < 24) val = (i == 8 * go + gm - 16) ? cwv[jj] : 0.f; }
                else if (gm >= 24) val = (kk == 8 * (go & 1) + gm - 24) ? 1.0f : 0.f;
                v[jj] = val; }
            v4u wq; wq.x = pk2(v[0], v[1]); wq.y = pk2(v[2], v[3]); wq.z = pk2(v[4], v[5]); wq.w = pk2(v[6], v[7]);
            *(v4u*)(F.GT + (size_t)gt * 8) = wq; }
        { const float sa = wave_sum(ccb * cga), sx = wave_sum(ccb * cgx);
          if (hasC && lane == 0) { const float lm = F.lam[cch]; const float sp = log1pf(__expf(-lm));
            f32x4 o; o[0] = sa + F.gab[cch]; o[1] = sx + F.gxb[cch]; o[2] = F.conv_b[cch]; o[3] = -8.0f * sp * LOG2E;
            *(f32x4*)(F.CT + 4 * cch) = o; } }
        if (hasD) { LAS float* scr = (LAS float*)(F.lds + F.wave * 8448);
            tr_put(scr, lane, dv); LDS_WAIT(); asm volatile("" ::: "memory");
            tr_store(tj, titem, lane, scr); LDS_WAIT(); asm volatile("" ::: "memory"); }
        __syncthreads();
        p0_strips<0, true>(F, F.vcu, F.G, NS_P0, sva);
        return;
    }
    for (int it = blockIdx.x; it < 256; it += F.G) {
        LAS float* cact = (LAS float*)F.lds; LAS float* red = (LAS float*)(F.lds + 4096);
        const int kq = it >> 6, nc = it & 63;
        for (int i = tid; i < 1024; i += NTHREADS) { const float cv = F.c[(i >> 8) * D + 256 * kq + (i & 255)]; cact[i] = cv / (1.0f + __expf(-cv)); }
        __syncthreads();
        if (tid < 384) {
            const int c4 = tid % 24, kl = tid / 24;
            f32x4 a0 = {0.f, 0.f, 0.f, 0.f}, a1 = a0, a2 = a0, a3 = a0;
            const float* wp = F.w_ada + (size_t)(256 * kq + kl) * 6144 + 96 * nc + 4 * c4;
            f32x4 wv[16];
#pragma unroll
            for (int j = 0; j < 16; ++j) wv[j] = *(const f32x4*)(wp + (size_t)(16 * j) * 6144);
#pragma unroll
            for (int j = 0; j < 16; ++j) { const int k = kl + 16 * j; a0 += cact[k] * wv[j]; a1 += cact[256 + k] * wv[j]; a2 += cact[512 + k] * wv[j]; a3 += cact[768 + k] * wv[j]; }
            *(LAS f32x4*)(red + (kl * 4 + 0) * 96 + 4 * c4) = a0; *(LAS f32x4*)(red + (kl * 4 + 1) * 96 + 4 * c4) = a1;
            *(LAS f32x4*)(red + (kl * 4 + 2) * 96 + 4 * c4) = a2; *(LAS f32x4*)(red + (kl * 4 + 3) * 96 + 4 * c4) = a3;
        }
        __syncthreads();
        if (tid < 384) { const int b = tid / 96, col = tid % 96; float s = 0.f;
#pragma unroll
            for (int kl = 0; kl < 16; ++kl) s += red[(kl * 4 + b) * 96 + col];
            F.modp[(kq * 4 + b) * 6144 + 96 * nc + col] = s; }
        __syncthreads();
    }
    for (int it = blockIdx.x; it < 256; it += F.G) {
        LAS float* win = (LAS float*)F.lds;
        for (int i = tid; i < 2048; i += NTHREADS) win[i] = F.w_in[(size_t)(4 * it + (i >> 9)) * INW + 1024 + (i & 511)];
        __syncthreads();
        { const int g = tid >> 7, d = tid & 127; float a0 = 0.f, a1 = 0.f, a2 = 0.f, a3 = 0.f;
          const float* pw = F.pool_w + (size_t)g * 128 * 128 + d; LAS const float* wl = win + 128 * g;
#pragma unroll 16
          for (int cc = 0; cc < 128; ++cc) { const float p = pw[cc * 128]; a0 += wl[cc] * p; a1 += wl[512 + cc] * p; a2 += wl[1024 + cc] * p; a3 += wl[1536 + cc] * p; }
          v2u o; o.x = pk2(a0, a1); o.y = pk2(a2, a3);
          *(v2u*)(F.WIN + (size_t)(1024 + tid) * D + 4 * it) = o; }
        __syncthreads();
    }
    for (int gt = blockIdx.x * NTHREADS + tid; gt < 64 * 17 * 64; gt += F.G * NTHREADS) {
        const int l = gt & 63, s = (gt >> 6) % 17, un = gt / (64 * 17), h = un >> 3, o = un & 7, m = l & 31, kk0 = 8 * (l >> 5);
        float v[8];
#pragma unroll
        for (int jj = 0; jj < 8; ++jj) { const int kk = kk0 + jj; float val = 0.f;
            if (s < 16) { const int tap = s >> 2, i = 16 * (s & 3) + kk; const float cw = F.conv_w[tap * LRU + 64 * h + i];
                if (m < 8) val = cw * F.gaw[(size_t)(h * 64 + i) * 64 + 8 * o + m];
                else if (m < 16) val = cw * F.gxw[(size_t)(h * 64 + i) * 64 + 8 * o + m - 8];
                else if (m < 24) val = (i == 8 * o + m - 16) ? cw : 0.f;
            } else if (m >= 24) val = (kk == 8 * (o & 1) + m - 24) ? 1.0f : 0.f;
            v[jj] = val; }
        v4u w; w.x = pk2(v[0], v[1]); w.y = pk2(v[2], v[3]); w.z = pk2(v[4], v[5]); w.w = pk2(v[6], v[7]);
        *(v4u*)(F.GT + (size_t)gt * 8) = w;
    }
    for (int ch = blockIdx.x * NWAVES + F.wave; ch < LRU; ch += F.G * NWAVES) {
        const int h = ch >> 6, jn = ch & 63; const float cb = F.conv_b[64 * h + lane];
        const float sa = wave_sum(cb * F.gaw[(size_t)(h * 64 + lane) * 64 + jn]), sx = wave_sum(cb * F.gxw[(size_t)(h * 64 + lane) * 64 + jn]);
        if (lane == 0) { const float lm = F.lam[ch]; const float sp = log1pf(__expf(-lm));
            f32x4 o; o[0] = sa + F.gab[ch]; o[1] = sx + F.gxb[ch]; o[2] = F.conv_b[ch]; o[3] = -8.0f * sp * LOG2E;
            *(f32x4*)(F.CT + 4 * ch) = o; }
    }
    {
        LAS float* scr = (LAS float*)(F.lds + F.wave * 8448);
        const int gw = F.vcu * NWAVES + F.wave, NGW = F.G * NWAVES;
        constexpr int NITEMS = 512 + 512;
        TrJob j; int item = 0; f32x4 v[8];
        for (int it = gw; it < NITEMS; it += NGW) {
            if (!tr_job(F, it, j, item)) break;
            tr_load(j, item, lane, v); tr_put(scr, lane, v);
            LDS_WAIT(); asm volatile("" ::: "memory");
            tr_store(j, item, lane, scr);
            LDS_WAIT(); asm volatile("" ::: "memory");
        }
    }
    __syncthreads();
    { f32x4 sva[16]; p0_strips<0, false>(F, F.vcu, F.G, NS_P0, sva); }
}

__device__ __forceinline__ void p1_prenorm(Frame& F) {
    LAS float* cH = (LAS float*)F.lds; LAS float* sh = cH + D;
    for (int rb = F.vcu; rb < T / 64; rb += F.G) {
        const int row0 = 64 * rb, b = row0 / SEQ;
        __syncthreads();
        for (int i = F.tid; i < D; i += NTHREADS) { cH[i] = F.g_mix_pre[i] * (1.0f + modv(F, b, D + i)); sh[i] = modv(F, b, i); }
        __syncthreads();
        for (int j = 0; j < 8; ++j) {
            const int row = row0 + 8 * F.wave + j; const f32x4* xr = (const f32x4*)(F.x + (size_t)row * D) + F.lane;
            f32x4 v[4]; float ss = 0.f;
#pragma unroll
            for (int q = 0; q < 4; ++q) { v[q] = xr[64 * q]; ss += (v[q][0] * v[q][0] + v[q][1] * v[q][1]) + (v[q][2] * v[q][2] + v[q][3] * v[q][3]); }
            const float rstd = rsqrtf(wave_sum(ss) * (1.0f / D) + EPS);
            v2u* o8 = (v2u*)(F.H + (size_t)row * D) + F.lane;
#pragma unroll
            for (int q = 0; q < 4; ++q) { const f32x4 cc = *(LAS const f32x4*)(cH + 4 * F.lane + 256 * q), ss4 = *(LAS const f32x4*)(sh + 4 * F.lane + 256 * q);
                const f32x4 hv = v[q] * rstd * cc + ss4; v2u w; w.x = pk2(hv[0], hv[1]); w.y = pk2(hv[2], hv[3]); o8[64 * q] = w; }
        }
    }
}

template <int WD> __device__ __forceinline__ void pool_run(const bf16* vp, bf16* op, int t, const float (&pb)[8], const float (&ps)[8]) {
    constexpr int NR = WD + 7;
    v4u r[NR];
#pragma unroll
    for (int k = 0; k < NR; ++k) { r[k] = (v4u){0u, 0u, 0u, 0u}; if (t - (WD - 1) + k >= 0) r[k] = *(const v4u*)(vp + (long)(k - (WD - 1)) * INW); }
    float s[8] = {0.f, 0.f, 0.f, 0.f, 0.f, 0.f, 0.f, 0.f};
#pragma unroll
    for (int k = 0; k < WD - 1; ++k) { if ((k & 3) == 3) __builtin_amdgcn_sched_barrier(0); s[0] += bf_lo(r[k].x); s[1] += bf_hi(r[k].x); s[2] += bf_lo(r[k].y); s[3] += bf_hi(r[k].y); s[4] += bf_lo(r[k].z); s[5] += bf_hi(r[k].z); s[6] += bf_lo(r[k].w); s[7] += bf_hi(r[k].w); }
#pragma unroll
    for (int i = 0; i < 8; ++i) {
        const v4u q = r[WD - 1 + i];
        const float cv[8] = {bf_lo(q.x), bf_hi(q.x), bf_lo(q.y), bf_hi(q.y), bf_lo(q.z), bf_hi(q.z), bf_lo(q.w), bf_hi(q.w)};
        const int cnt = (t + i + 1) < WD ? (t + i + 1) : WD; const float rc = 1.0f / (float)cnt;
        float ov[8];
#pragma unroll
        for (int x = 0; x < 8; ++x) { s[x] += cv[x]; ov[x] = (s[x] * rc - cv[x] + pb[x]) * ps[x]; }
        v4u ow; ow.x = pk2(ov[0], ov[1]); ow.y = pk2(ov[2], ov[3]); ow.z = pk2(ov[4], ov[5]); ow.w = pk2(ov[6], ov[7]);
        *(v4u*)(op + (size_t)i * D) = ow;
        const v4u z = r[i];
        s[0] -= bf_lo(z.x); s[1] -= bf_hi(z.x); s[2] -= bf_lo(z.y); s[3] -= bf_hi(z.y); s[4] -= bf_lo(z.z); s[5] -= bf_hi(z.z); s[6] -= bf_lo(z.w); s[7] -= bf_hi(z.w);
        __builtin_amdgcn_sched_barrier(0);
    }
}
constexpr int XS_PITCH = 144, P3_AB = 74752, P3_YS = 123904;
__device__ __forceinline__ void p3_mixer(Frame& F) {
    const int tid = F.tid, lane = F.lane, w = F.wave, hh = lane >> 5, tl = lane & 31;
    LAS unsigned char* XS = F.lds;
    LAS float* ABa = (LAS float*)(F.lds + P3_AB); LAS float* ABb = ABa + 8 * 512; LAS float* ABg = ABb + 8 * 512;
    LAS bf16* YS = (LAS bf16*)(F.lds + P3_YS);
    for (int unit = F.vcu; unit < 256; unit += F.G) {
        const int b = unit >> 6, h = (unit >> 3) & 7, o = unit & 7;
        bf16x8 Af[17];
        { const bf16x8* gt = (const bf16x8*)F.GT + (size_t)((h * 8 + o) * 17) * 64 + lane;
#pragma unroll
          for (int s = 0; s < 17; ++s) Af[s] = gt[s * 64]; }
        float br[4], bi[4], bx[4], kc[4];
#pragma unroll
        for (int x = 0; x < 4; ++x) { const f32x4 c4 = *(const f32x4*)(F.CT + 4 * (64 * h + 8 * o + 4 * hh + x)); br[x] = c4[0]; bi[x] = c4[1]; bx[x] = c4[2]; kc[x] = c4[3]; }
        float carry = 0.f;
        const bf16* Ub = F.U + (size_t)(b * SEQ) * INW;
        __syncthreads();
        if (tid < 24) *(LAS v4u*)(XS + (tid >> 3) * XS_PITCH + (tid & 7) * 16) = (v4u){0u, 0u, 0u, 0u};
        v4u xr[8];
#pragma unroll
        for (int j = 0; j < 8; ++j) { const int p = tid + 512 * j; xr[j] = *(const v4u*)(Ub + (size_t)(p >> 3) * INW + 64 * h + 8 * (p & 7)); }
        for (int ck = 0; ck < 8; ++ck) {
            const int t0 = 512 * ck;
#pragma unroll
            for (int j = 0; j < 8; ++j) { const int p = tid + 512 * j; *(LAS v4u*)(XS + (3 + (p >> 3)) * XS_PITCH + (p & 7) * 16) = xr[j]; }
            bf16x8 gaf[2];
#pragma unroll
            for (int tile = 0; tile < 2; ++tile) gaf[tile] = *(const bf16x8*)(Ub + (size_t)(t0 + 64 * w + 32 * tile + tl) * INW + 512 + 64 * h + 16 * (o >> 1) + 8 * hh);
            __syncthreads();
            if (ck < 7) {
#pragma unroll
                for (int j = 0; j < 8; ++j) { const int p = tid + 512 * j; xr[j] = *(const v4u*)(Ub + (size_t)(t0 + 512 + (p >> 3)) * INW + 64 * h + 8 * (p & 7)); }
            }
#pragma unroll
            for (int tile = 0; tile < 2; ++tile) {
                const int tt = 64 * w + 32 * tile + tl;
                f32x16 acc;
#pragma unroll
                for (int i = 0; i < 16; ++i) acc[i] = 0.f;
#pragma unroll
                for (int s = 0; s < 16; ++s) { const int tap = s >> 2, q = s & 3;
                    const bf16x8 bf = *(LAS const bf16x8*)(XS + (tt + 3 - tap) * XS_PITCH + 32 * q + 16 * hh);
                    acc = __builtin_amdgcn_mfma_f32_32x32x16_bf16(Af[s], bf, acc, 0, 0, 0); if ((s & 3) == 3) __builtin_amdgcn_sched_barrier(0); }
                acc = __builtin_amdgcn_mfma_f32_32x32x16_bf16(Af[16], gaf[tile], acc, 0, 0, 0);
#pragma unroll
                for (int x = 0; x < 4; ++x) {
                    const float r = fast_sigmoid(acc[x] + br[x]), ig = fast_sigmoid(acc[4 + x] + bi[x]), xc = acc[8 + x] + bx[x];
                    const float a = __builtin_amdgcn_exp2f(r * kc[x]);
                    const float mult = __builtin_amdgcn_sqrtf(fmaxf(1.0f - a * a, 0.f));
                    const int idx = (4 * hh + x) * 512 + tt;
                    ABa[idx] = a; ABb[idx] = mult * ig * xc; ABg[idx] = gelu_tanh(acc[12 + x]);
                }
            }
            __syncthreads();
            if (tid < 24) *(LAS v4u*)(XS + (tid >> 3) * XS_PITCH + (tid & 7) * 16) = *(LAS const v4u*)(XS + (512 + (tid >> 3)) * XS_PITCH + (tid & 7) * 16);
            {
                const f32x4 a0 = *(LAS const f32x4*)(ABa + w * 512 + 8 * lane), a1 = *(LAS const f32x4*)(ABa + w * 512 + 8 * lane + 4);
                const f32x4 b0 = *(LAS const f32x4*)(ABb + w * 512 + 8 * lane), b1 = *(LAS const f32x4*)(ABb + w * 512 + 8 * lane + 4);
                const f32x4 g0 = *(LAS const f32x4*)(ABg + w * 512 + 8 * lane), g1 = *(LAS const f32x4*)(ABg + w * 512 + 8 * lane + 4);
                float av[8] = {a0[0], a0[1], a0[2], a0[3], a1[0], a1[1], a1[2], a1[3]}, bv[8] = {b0[0], b0[1], b0[2], b0[3], b1[0], b1[1], b1[2], b1[3]};
                float gv[8] = {g0[0], g0[1], g0[2], g0[3], g1[0], g1[1], g1[2], g1[3]};
                float hl[8], pc[8]; float hcur = 0.f, pcur = 1.f;
#pragma unroll
                for (int i = 0; i < 8; ++i) { hcur = av[i] * hcur + bv[i]; pcur *= av[i]; hl[i] = hcur; pc[i] = pcur; }
                float A = pcur, B = hcur;
#pragma unroll
                for (int d = 1; d < 64; d <<= 1) { const float Ap = __shfl_up(A, d), Bp = __shfl_up(B, d); if (lane >= d) { B = A * Bp + B; A = A * Ap; } }
                float Ae = __shfl_up(A, 1), Be = __shfl_up(B, 1); if (lane == 0) { Ae = 1.f; Be = 0.f; }
                const float hin = Ae * carry + Be;
                float hv[8];
#pragma unroll
                for (int i = 0; i < 8; ++i) hv[i] = hl[i] + pc[i] * hin;
                carry = __shfl(hv[7], 63);
                { v4u yw; yw.x = pk2(hv[0] * gv[0], hv[1] * gv[1]); yw.y = pk2(hv[2] * gv[2], hv[3] * gv[3]); yw.z = pk2(hv[4] * gv[4], hv[5] * gv[5]); yw.w = pk2(hv[6] * gv[6], hv[7] * gv[7]);
                  *(LAS v4u*)(YS + w * 512 + 8 * lane) = yw; }
            }
            __syncthreads();
            { unsigned y[8];
#pragma unroll
              for (int c8 = 0; c8 < 8; ++c8) y[c8] = YS[c8 * 512 + tid];
              v4u ow; ow.x = y[0] | (y[1] << 16); ow.y = y[2] | (y[3] << 16); ow.z = y[4] | (y[5] << 16); ow.w = y[6] | (y[7] << 16);
              *(v4u*)(F.MIXIN + (size_t)(b * SEQ + t0 + tid) * D + 64 * h + 8 * o) = ow; }
        }
    }
    for (int it = F.vcu; it < 256; it += F.G) {
        int lv = lane; asm volatile("" : "+v"(lv));
        const int g = w & 3, cg = 16 * g + (lv & 15), run = it * 8 + (w >> 2) * 4 + (lv >> 4), row0 = 8 * run, t = row0 & (SEQ - 1);
        const bf16* vp = F.U + (size_t)row0 * INW + 1024 + 8 * cg; bf16* op = F.MIXIN + (size_t)row0 * D + 512 + 8 * cg;
        float pb[8], ps[8];
        { const f32x4 pb0 = *(const f32x4*)(F.pool_b + 8 * cg), pb1 = *(const f32x4*)(F.pool_b + 8 * cg + 4), ps0 = *(const f32x4*)(F.pool_s + 8 * cg), ps1 = *(const f32x4*)(F.pool_s + 8 * cg + 4);
#pragma unroll
          for (int x = 0; x < 4; ++x) { pb[x] = pb0[x]; pb[4 + x] = pb1[x]; ps[x] = ps0[x]; ps[4 + x] = ps1[x]; } }
        if (g == 0) pool_run<2>(vp, op, t, pb, ps); else if (g == 1) pool_run<4>(vp, op, t, pb, ps); else if (g == 2) pool_run<8>(vp, op, t, pb, ps); else pool_run<16>(vp, op, t, pb, ps);
    }
}

constexpr int P5_HL_PITCH = 4112;
constexpr int P5_HL = 0, P5_PART = 16 * P5_HL_PITCH, P5_LOG = P5_PART + 8 * 16 * 32 * 4;
constexpr int P5_VEC = AUX_OFF;
constexpr int P5_MISC = LDSCTL_OFF + 64;
static_assert(P5_MISC + 2304 + 256 <= LDS_BYTES && P5_LOG + 2048 <= RING_BYTES, "LDS map");
__device__ __forceinline__ void p5_rows(Frame& F) {
    const int tid = F.tid, lane = F.lane, w = F.wave;
    LAS unsigned char* HL = F.lds + P5_HL; LAS float* PART = (LAS float*)(F.lds + P5_PART); LAS float* LOG = (LAS float*)(F.lds + P5_LOG);
    LAS float* cA = (LAS float*)(F.lds + P5_VEC); LAS float* cB = cA + D; LAS float* shF = cB + D;
    LAS int* lcnt = (LAS int*)(F.lds + P5_MISC); LAS int* lbase = lcnt + 32; LAS int* rowe = lbase + 32; LAS int* rowr = rowe + 256; LAS float* rows_s = (LAS float*)(rowr + 256);
    bf16x8 Bh[4][2], Bl[4][2];
#pragma unroll
    for (int s4 = 0; s4 < 4; ++s4)
#pragma unroll
        for (int nb = 0; nb < 2; ++nb) { unsigned hw[4], lw[4];
#pragma unroll
            for (int jj = 0; jj < 4; ++jj) { const int k = 128 * w + 32 * s4 + 8 * (lane >> 4) + 2 * jj; const float v0 = F.router_w[(size_t)k * NE + 16 * nb + (lane & 15)], v1 = F.router_w[(size_t)(k + 1) * NE + 16 * nb + (lane & 15)];
                const unsigned h = pk2(v0, v1); hw[jj] = h; lw[jj] = pk2(v0 - bf_lo(h), v1 - bf_hi(h)); }
            Bh[s4][nb] = __builtin_bit_cast(bf16x8, (v4u){hw[0], hw[1], hw[2], hw[3]}); Bl[s4][nb] = __builtin_bit_cast(bf16x8, (v4u){lw[0], lw[1], lw[2], lw[3]}); }
    for (int rb = F.vcu; rb < T / 64; rb += F.G) {
        const int row0 = 64 * rb, b = row0 / SEQ;
        __syncthreads();
        for (int i = tid; i < D; i += NTHREADS) { cA[i] = modv(F, b, 2 * D + i) * F.g_mix_post[i]; cB[i] = F.g_ffn_pre[i] * (1.0f + modv(F, b, 4 * D + i)); shF[i] = modv(F, b, 3 * D + i); }
        if (tid < 32) lcnt[tid] = 0;
        __syncthreads();
#pragma unroll 1
        for (int ps = 0; ps < 4; ++ps) {
#pragma unroll
            for (int rr = 0; rr < 2; ++rr) {
                const int rl = 16 * ps + 2 * w + rr, row = row0 + rl;
                float hA[16];
                f32x4 xv[4], mv[4]; float ss = 0.f;
#pragma unroll
                for (int q = 0; q < 4; ++q) { xv[q] = *((const f32x4*)(F.x + (size_t)row * D) + lane + 64 * q); const v2u mw = *((const v2u*)(F.MIX + (size_t)row * D) + lane + 64 * q);
                    mv[q] = (f32x4){bf_lo(mw.x), bf_hi(mw.x), bf_lo(mw.y), bf_hi(mw.y)}; ss += (mv[q][0] * mv[q][0] + mv[q][1] * mv[q][1]) + (mv[q][2] * mv[q][2] + mv[q][3] * mv[q][3]); }
                const float rs = rsqrtf(wave_sum(ss) * (1.0f / D) + EPS); float s1 = 0.f;
#pragma unroll
                for (int q = 0; q < 4; ++q) { const f32x4 ca = *(LAS const f32x4*)(cA + 4 * lane + 256 * q); xv[q] = xv[q] + ca * (mv[q] * rs);
                    { v2u xw; xw.x = pk2(xv[q][0], xv[q][1]); xw.y = pk2(xv[q][2], xv[q][3]); *((v2u*)(F.X1 + (size_t)row * D) + lane + 64 * q) = xw; } s1 += (xv[q][0] * xv[q][0] + xv[q][1] * xv[q][1]) + (xv[q][2] * xv[q][2] + xv[q][3] * xv[q][3]); }
                const float r1 = rsqrtf(wave_sum(s1) * (1.0f / D) + EPS);
#pragma unroll
                for (int q = 0; q < 4; ++q) { const f32x4 cb = *(LAS const f32x4*)(cB + 4 * lane + 256 * q), sf = *(LAS const f32x4*)(shF + 4 * lane + 256 * q);
                    const f32x4 hv = xv[q] * r1 * cb + sf;
                    hA[4 * q + 0] = hv[0]; hA[4 * q + 1] = hv[1]; hA[4 * q + 2] = hv[2]; hA[4 * q + 3] = hv[3]; }
                float am = 0.f;
#pragma unroll
                for (int i = 0; i < 16; ++i) am = fmaxf(am, fabsf(hA[i]));
#pragma unroll
                for (int o = 1; o < 64; o <<= 1) am = fmaxf(am, __shfl_xor(am, o));
                const float sc = am > 0.f ? am * (1.0f / 448.0f) : 1.0f, iv = 1.0f / sc;
                if (lane == 0) rows_s[rl] = sc;
                LAS unsigned char* hr = HL + (2 * w + rr) * P5_HL_PITCH + 8 * lane;
#pragma unroll
                for (int q = 0; q < 4; ++q) { *((unsigned*)(F.H2 + (size_t)row * D) + lane + 64 * q) = pk4_fp8(hA[4 * q] * iv, hA[4 * q + 1] * iv, hA[4 * q + 2] * iv, hA[4 * q + 3] * iv);
                    const unsigned h0 = pk2(hA[4 * q], hA[4 * q + 1]), h1 = pk2(hA[4 * q + 2], hA[4 * q + 3]);
                    const unsigned l0 = pk2(hA[4 * q] - bf_lo(h0), hA[4 * q + 1] - bf_hi(h0)), l1 = pk2(hA[4 * q + 2] - bf_lo(h1), hA[4 * q + 3] - bf_hi(h1));
                    *(LAS v2u*)(hr + 512 * q) = (v2u){h0, h1}; *(LAS v2u*)(hr + 2048 + 512 * q) = (v2u){l0, l1}; }
            }
            __syncthreads();
            {   f32x4 acc0 = {0.f, 0.f, 0.f, 0.f}, acc1 = acc0;
                LAS const unsigned char* ap = HL + (lane & 15) * P5_HL_PITCH + 2 * (128 * w + 8 * (lane >> 4));
#pragma unroll
                for (int s4 = 0; s4 < 4; ++s4) { const bf16x8 ah = *(LAS const bf16x8*)(ap + 64 * s4), al = *(LAS const bf16x8*)(ap + 2048 + 64 * s4);
                    acc0 = __builtin_amdgcn_mfma_f32_16x16x32_bf16(ah, Bh[s4][0], acc0, 0, 0, 0); acc1 = __builtin_amdgcn_mfma_f32_16x16x32_bf16(ah, Bh[s4][1], acc1, 0, 0, 0);
                    acc0 = __builtin_amdgcn_mfma_f32_16x16x32_bf16(ah, Bl[s4][0], acc0, 0, 0, 0); acc1 = __builtin_amdgcn_mfma_f32_16x16x32_bf16(ah, Bl[s4][1], acc1, 0, 0, 0);
                    acc0 = __builtin_amdgcn_mfma_f32_16x16x32_bf16(al, Bh[s4][0], acc0, 0, 0, 0); acc1 = __builtin_amdgcn_mfma_f32_16x16x32_bf16(al, Bh[s4][1], acc1, 0, 0, 0); }
#pragma unroll
                for (int rg = 0; rg < 4; ++rg) { LAS float* pp = PART + (w * 16 + 4 * (lane >> 4) + rg) * 32 + (lane & 15); pp[0] = acc0[rg]; pp[16] = acc1[rg]; }
            }
            __syncthreads();
            { float sum = F.router_b[tid & 31];
#pragma unroll
              for (int ww = 0; ww < 8; ++ww) sum += PART[ww * 512 + tid];
              LOG[tid] = sum; }
            __syncthreads();
            {
                const int rl = 16 * ps + 2 * w + (lane >> 5), row = row0 + rl, me = lane & 31;
                float val = LOG[(2 * w + (lane >> 5)) * 32 + me];
                float tv[4]; int te[4];
#pragma unroll
                for (int k = 0; k < 4; ++k) { float m = val; int mi = me;
#pragma unroll
                    for (int d = 1; d < 32; d <<= 1) { const float om = __shfl_xor(m, d); const int oi = __shfl_xor(mi, d); if (om > m || (om == m && oi < mi)) { m = om; mi = oi; } }
                    tv[k] = m; te[k] = mi; if (me == mi) val = -3.0e38f; }
                const float e1 = __expf(tv[1] - tv[0]), e2 = __expf(tv[2] - tv[0]), e3 = __expf(tv[3] - tv[0]); const float inv = 1.0f / (1.0f + e1 + e2 + e3);
                if (me == 0) {
                    const float gts[4] = {inv, e1 * inv, e2 * inv, e3 * inv};
#pragma unroll
                    for (int k = 0; k < 4; ++k) { const int lr = __hip_atomic_fetch_add(lcnt + te[k], 1, __ATOMIC_RELAXED, __HIP_MEMORY_SCOPE_WORKGROUP); rowe[4 * rl + k] = te[k]; rowr[4 * rl + k] = lr; F.gate[(size_t)row * 4 + k] = gts[k]; }
                }
            }
        }
        __syncthreads();
        if (tid < 32) { const int n = lcnt[tid]; lbase[tid] = n ? (int)__hip_atomic_fetch_add((unsigned*)(F.ctl + CW_CNT + 64 * tid), (unsigned)n, RLX_AGENT) : 0; }
        __syncthreads();
        if (tid < 256) { const int e = rowe[tid], rank = lbase[e] + rowr[tid], row = row0 + (tid >> 2);
            F.list[(size_t)e * LISTCAP + rank] = row; F.scl[(size_t)e * LISTCAP + rank] = rows_s[tid >> 2]; F.slot[(size_t)row * 4 + (tid & 3)] = ((unsigned)e << 16) | (unsigned)rank; }
    }
}

__device__ __forceinline__ int moe_setup(Frame& F, int NT) {
    LAS int* aux = (LAS int*)(F.lds + AUX_OFF);
    __syncthreads();
    if (F.tid < 32) aux[F.tid] = (int)__hip_atomic_load((unsigned*)(F.ctl + CW_CNT + 64 * F.tid), RLX_AGENT);
    __syncthreads();
    if (F.tid == 0) { int tp = 0; for (int e = 0; e < NE; ++e) { aux[32 + e] = tp; tp += (aux[e] + 255) >> 8; } aux[64] = tp; }
    __syncthreads();
    const int total = aux[64] * NT;
    if (F.tid < 64) { const long L = (long)F.tid * F.G + F.vcu; int e = -1, mt = 0, mg = 0, pn = 0;
        if (L < total) { mg = (int)(L / NT); pn = (int)(L % NT); e = 0; for (int q = 1; q < NE; ++q) if (aux[32 + q] <= mg) e = q; mt = mg - aux[32 + e]; }
        aux[128 + 4 * F.tid + 0] = e; aux[128 + 4 * F.tid + 1] = mt; aux[128 + 4 * F.tid + 2] = mg; aux[128 + 4 * F.tid + 3] = pn; }
    __syncthreads();
    int n = 0; for (int i = 0; i < 64; ++i) if (aux[128 + 4 * i] >= 0) n = i + 1;
    return __builtin_amdgcn_readfirstlane(n);
}

__device__ __forceinline__ void p8_final(Frame& F) {
    LAS float* cF = (LAS float*)F.lds; LAS int* aux = (LAS int*)(F.lds + AUX_OFF);
    __syncthreads();
    if (F.tid < 32) aux[F.tid] = (int)__hip_atomic_load((unsigned*)(F.ctl + CW_CNT + 64 * F.tid), RLX_AGENT);
    __syncthreads();
    if (F.tid == 0) { int tp = 0; for (int e = 0; e < NE; ++e) { aux[32 + e] = tp; tp += (aux[e] + 255) >> 8; } }
    for (int rb = F.vcu; rb < T / 64; rb += F.G) {
        const int row0 = 64 * rb, b = row0 / SEQ;
        __syncthreads();
        for (int i = F.tid; i < D; i += NTHREADS) cF[i] = modv(F, b, 5 * D + i) * F.g_ffn_post[i];
        __syncthreads();
        for (int j = 0; j < 8; ++j) {
            const int row = row0 + 8 * F.wave + j;
            const v4u sl = *(const v4u*)(F.slot + (size_t)row * 4); const f32x4 gt = *(const f32x4*)(F.gate + (size_t)row * 4);
            const unsigned sv[4] = {sl.x, sl.y, sl.z, sl.w};
            float f[16];
#pragma unroll
            for (int i = 0; i < 16; ++i) f[i] = 0.f;
#pragma unroll
            for (int k = 0; k < 4; ++k) { const int e = (int)(sv[k] >> 16), pos = 256 * aux[32 + e] + (int)(sv[k] & 0xffffu); const float gk = gt[k];
                const v4u* yr = (const v4u*)(F.Y + (size_t)pos * D) + F.lane;
#pragma unroll
                for (int q = 0; q < 2; ++q) { const v4u y = yr[64 * q];
                    f[8 * q + 0] += gk * bf_lo(y.x); f[8 * q + 1] += gk * bf_hi(y.x); f[8 * q + 2] += gk * bf_lo(y.y); f[8 * q + 3] += gk * bf_hi(y.y);
                    f[8 * q + 4] += gk * bf_lo(y.z); f[8 * q + 5] += gk * bf_hi(y.z); f[8 * q + 6] += gk * bf_lo(y.w); f[8 * q + 7] += gk * bf_hi(y.w); } }
            float ss = 0.f;
#pragma unroll
            for (int i = 0; i < 16; ++i) ss += f[i] * f[i];
            const float rs = rsqrtf(wave_sum(ss) * (1.0f / D) + EPS);
#pragma unroll
            for (int q = 0; q < 2; ++q)
#pragma unroll
                for (int hq = 0; hq < 2; ++hq) { const int col = 512 * q + 8 * F.lane + 4 * hq; const v2u xw = *(const v2u*)(F.X1 + (size_t)row * D + col); f32x4* op = (f32x4*)(F.out2 + (size_t)row * D + col); const f32x4 x1 = {bf_lo(xw.x), bf_hi(xw.x), bf_lo(xw.y), bf_hi(xw.y)}, cf = *(LAS const f32x4*)(cF + col);
                    f32x4 fv = {f[8 * q + 4 * hq], f[8 * q + 4 * hq + 1], f[8 * q + 4 * hq + 2], f[8 * q + 4 * hq + 3]};
                    *op = x1 + cf * (fv * rs); }
        }
    }
}

struct Args { const float* in[26]; float* out; float* out2; unsigned char* ws; int ph_lo, ph_hi; };
__global__ void __launch_bounds__(NTHREADS, 2) fwd_kernel(Args args) {
    extern __shared__ __attribute__((aligned(16))) unsigned char lds[];
    Frame F;
    F.lds = (LAS unsigned char*)lds;
    F.tid = threadIdx.x; F.lane = F.tid & 63; F.wave = __builtin_amdgcn_readfirstlane(F.tid >> 6);
    F.G = gridDim.x; { const int bx = blockIdx.x; F.vcu = (F.G % 8 == 0) ? (bx % 8) * (F.G / 8) + bx / 8 : bx; }
    unsigned char* ws = args.ws;
    F.ctl = (gu32*)(ws + WS_CTL); F.ws = ws;
    F.x = args.in[0]; F.c = args.in[1]; F.w_ada = args.in[2]; F.b_ada = args.in[3]; F.g_mix_pre = args.in[4]; F.g_mix_post = args.in[5]; F.w_in = args.in[6];
    F.conv_w = args.in[7]; F.conv_b = args.in[8]; F.gaw = args.in[9]; F.gab = args.in[10]; F.gxw = args.in[11]; F.gxb = args.in[12]; F.lam = args.in[13];
    F.pool_w = args.in[14]; F.pool_b = args.in[15]; F.pool_s = args.in[16]; F.w_out = args.in[17]; F.g_ffn_pre = args.in[18]; F.g_ffn_post = args.in[19];
    F.router_w = args.in[20]; F.router_b = args.in[21]; F.w1 = args.in[22]; F.b1 = args.in[23]; F.w2 = args.in[24]; F.b2 = args.in[25];
    F.out = args.out; F.out2 = args.out2;
    F.modp = (float*)(ws + WS_MODP); F.CT = (float*)(ws + WS_CT); F.gate = (float*)(ws + WS_GATE); F.GT = (bf16*)(ws + WS_GT); F.WIN = (bf16*)(ws + WS_WIN); F.WOUT = (bf16*)(ws + WS_WOUT);
    F.H = (bf16*)(ws + WS_H); F.U = (bf16*)(ws + WS_U); F.MIXIN = (bf16*)(ws + WS_MIXIN); F.MIX = (bf16*)(ws + WS_MIX); F.X1 = (bf16*)(ws + WS_X1); F.H2 = ws + WS_H2;
    F.W1T = ws + WS_W1; F.W2T = ws + WS_W2; F.ACT = ws + WS_ACT; F.Y = (bf16*)(ws + WS_Y); F.sW1 = (float*)(ws + WS_SW1); F.sW2 = (float*)(ws + WS_SW2); F.scl = (float*)(ws + WS_SCL); F.slot = (unsigned*)(ws + WS_SLOT); F.list = (int*)(ws + WS_LIST);
    for (int u = F.tid; u < (LDS_BYTES - LDSCTL_OFF) / 4; u += NTHREADS) ((LAS unsigned*)(F.lds + LDSCTL_OFF))[u] = 0u;
    __syncthreads();
    XcdBarrier bar; bar.bar = (unsigned*)(F.ctl + CW_BAR); bar.x = 0; bar.st = nullptr;
    if (N_LAUNCHES == 1) bar = xcd_barrier_post((unsigned*)(F.ctl + CW_BAR), (volatile LAS unsigned*)(F.lds + LDSCTL_OFF));
    const int lo = args.ph_lo, hi = args.ph_hi;
#ifndef PH_MASK
#define PH_MASK 0x1ff
#endif
#define IN(k) (((PH_MASK >> (k)) & 1) && lo <= (k) && (k) < hi)
#define SEAM(k) do { if (IN(k) && IN((k) + 1)) xcd_barrier(bar); } while (0)

#ifdef PROBE_EXP
    if (lo >= 100) { return; }
#endif
    if (IN(0)) { p0_prologue(F); SEAM(0); }
    if (IN(1)) { p1_prenorm(F); SEAM(1); }
    if (IN(2)) {
        pg8::StaticSched S; S.init(F.WIN, T, INW, D, F.G, (int)blockIdx.x);
        pg8::EpiBf16 E{F.U, INW, nullptr, 0};
        pg8::gemm_phase<pg8::EpiBf16, pg8::StaticSched>(F.lds, (const char*)F.H, D, S, E);
        if (F.G == 256 && blockIdx.x >= 128) { __syncthreads(); f32x4 sva[16]; p0_strips<0, false>(F, NS_P0 + ((int)blockIdx.x - 128), 128, NSTRIPS_ALL, sva); }
        else if (F.G != 256 && blockIdx.x == 0) { __syncthreads(); f32x4 sva[16]; p0_strips<0, false>(F, NS_P0, 1, NSTRIPS_ALL, sva); }
        SEAM(2);
    }
    if (IN(3)) { p3_mixer(F); SEAM(3); }
    if (IN(4)) {
        pg8::StaticSched S; S.init(F.WOUT, T, D, D, F.G, (int)blockIdx.x);
        pg8::EpiBf16 E{F.MIX, D, nullptr, 0};
        pg8::gemm_phase<pg8::EpiBf16, pg8::StaticSched>(F.lds, (const char*)F.MIXIN, D, S, E);
        SEAM(4);
    }
    if (IN(5)) { p5_rows(F); SEAM(5); }
    if (IN(6)) {
        const int nu = moe_setup(F, 8);
        LAS const int* aux = (LAS const int*)(F.lds + AUX_OFF);
        pg8::MoeSched<true> S{(const char*)F.W1T, (size_t)DE2 * 1024, aux + 128, aux, F.list, nu};
        pg8::EpiSwiglu8 E{F.ACT, F.b1, F.sW1, F.scl, aux};
        pg8::gemm_phase<pg8::EpiSwiglu8, pg8::MoeSched<true>>(F.lds, (const char*)F.H2, 512, S, E);
        SEAM(6);
    }
    if (IN(7)) {
        const int nu = moe_setup(F, 4);
        LAS const int* aux = (LAS const int*)(F.lds + AUX_OFF);
        pg8::MoeSched<false> S{(const char*)F.W2T, (size_t)D * 1024, aux + 128, aux, F.list, nu};
        pg8::EpiY8 E{F.Y, F.b2, F.sW2};
        pg8::gemm_phase<pg8::EpiY8, pg8::MoeSched<false>>(F.lds, (const char*)F.ACT, 512, S, E);
        SEAM(7);
    }
    if (IN(8)) { p8_final(F); }
#undef IN
#undef SEAM
}

extern "C" void kernel_launch(void* const* d_in, const int* in_sizes, int n_in, void* d_out, int out_size, void* d_ws, size_t ws_size, hipStream_t stream) {
    static int grid = 0;
    if (grid == 0) {
        if (n_in != 26 || out_size != T * D || ws_size < WS_END) { fprintf(stderr, "kernel_launch: unexpected shapes (n_in %d, out %d, ws %zu); nothing launched\n", n_in, out_size, ws_size); grid = -1; return; }
        int dev = 0, cus = 0, per_cu = 0;
        if (hipGetDevice(&dev) != hipSuccess || hipDeviceGetAttribute(&cus, hipDeviceAttributeMultiprocessorCount, dev) != hipSuccess) { grid = -1; return; }
        if (hipFuncSetAttribute((const void*)fwd_kernel, hipFuncAttributeMaxDynamicSharedMemorySize, LDS_BYTES) != hipSuccess) { fprintf(stderr, "kernel_launch: hipFuncSetAttribute failed\n"); grid = -1; return; }
        if (hipOccupancyMaxActiveBlocksPerMultiprocessor(&per_cu, (const void*)fwd_kernel, NTHREADS, LDS_BYTES) != hipSuccess || per_cu < 1) { fprintf(stderr, "kernel_launch: occupancy query says %d blocks per CU\n", per_cu); (void)hipGetLastError(); grid = -1; return; }
        grid = cus;
        if (grid > 256) grid = 256;
    }
    if (grid < 0) return;
    (void)hipMemsetAsync((char*)d_ws + WS_CTL, 0, CTL_ZERO_BYTES, stream);
    Args a{};
    for (int i = 0; i < 26; ++i) a.in[i] = (const float*)d_in[i];
    a.out = (float*)d_out; a.out2 = (float*)d_out; a.ws = (unsigned char*)d_ws;
#ifdef PROBE_EXP
    { a.ph_lo = PROBE_EXP; a.ph_hi = PROBE_EXP + 1; hipLaunchKernelGGL(fwd_kernel, dim3(grid), dim3(NTHREADS), LDS_BYTES, stream, a); }
#endif
    for (int li = 0; li < N_LAUNCHES; ++li) {
        a.ph_lo = (N_LAUNCHES == 1) ? 0 : li; a.ph_hi = (N_LAUNCHES == 1) ? N_PHASES : li + 1;
#ifdef PROBE_DUP
        if (N_LAUNCHES > 1 && li == 8 && ((PROBE_DUP >> li) & 1)) { a.out2 = (float*)((char*)d_ws + WS_END); hipLaunchKernelGGL(fwd_kernel, dim3(grid), dim3(NTHREADS), LDS_BYTES, stream, a); a.out2 = (float*)d_out; hipLaunchKernelGGL(fwd_kernel, dim3(grid), dim3(NTHREADS), LDS_BYTES, stream, a); continue; }
#endif
        hipLaunchKernelGGL(fwd_kernel, dim3(grid), dim3(NTHREADS), LDS_BYTES, stream, a);
#ifdef PROBE_DUP
        if (N_LAUNCHES > 1 && ((PROBE_DUP >> li) & 1)) {
            if (li == 5) (void)hipMemsetAsync((char*)d_ws + WS_CTL, 0, CTL_ZERO_BYTES, stream);
            hipLaunchKernelGGL(fwd_kernel, dim3(grid), dim3(NTHREADS), LDS_BYTES, stream, a);
        }
#endif
    }
}
```

```cpp
#include <hip/hip_runtime.h>
#include <cstdio>
#include <cstdint>

#ifndef MK_N_LAUNCHES
#define MK_N_LAUNCHES 1
#endif

#define GAS __attribute__((address_space(1)))
#define LAS __attribute__((address_space(3)))
typedef unsigned short bf16;
typedef unsigned v4u __attribute__((ext_vector_type(4)));
typedef unsigned v2u __attribute__((ext_vector_type(2)));
typedef float f32x2 __attribute__((ext_vector_type(2)));
typedef float f32x4 __attribute__((ext_vector_type(4)));
typedef float f32x16 __attribute__((ext_vector_type(16)));
typedef short bf16x8 __attribute__((ext_vector_type(8)));
typedef __bf16 bf16v2 __attribute__((ext_vector_type(2)));
typedef int v4i __attribute__((ext_vector_type(4)));
typedef int v8i __attribute__((ext_vector_type(8)));
typedef GAS unsigned gu32;

constexpr int NB = 4, SEQ = 4096, D = 1024, T = NB * SEQ;
constexpr int LRU = 512, INW = 1536, NE = 32, DE2 = 2048, LISTCAP = 16384;
constexpr float EPS = 1e-6f;
constexpr int NWAVES = 8, NTHREADS = 512;
constexpr int N_PHASES = 9;
constexpr int NSTRIPS_ALL = 3072, NS_TAIL_PER = 4, NS_P0 = NSTRIPS_ALL - 128 * NS_TAIL_PER;
constexpr int N_LAUNCHES = MK_N_LAUNCHES;
static_assert(N_LAUNCHES == 1 || N_LAUNCHES == N_PHASES, "MK_N_LAUNCHES is 1 or 9");
constexpr float LOG2E = 1.4426950408889634f;

constexpr size_t MiB = 1u << 20;
constexpr size_t WS_CTL = 0, CTL_ZERO_BYTES = 65536;
constexpr size_t WS_MODP = 1 * MiB;
constexpr size_t WS_CT = 1 * MiB + 512 * 1024;
constexpr size_t WS_GT = 2 * MiB;
constexpr size_t WS_SW1 = 3 * MiB + 256 * 1024;
constexpr size_t WS_SW2 = 3 * MiB + 512 * 1024;
constexpr size_t WS_SCL = 14 * MiB;
constexpr size_t WS_WIN = 4 * MiB;
constexpr size_t WS_WOUT = 8 * MiB;
constexpr size_t WS_SLOT = 10 * MiB;
constexpr size_t WS_GATE = 11 * MiB;
constexpr size_t WS_LIST = 12 * MiB;
constexpr size_t WS_H = 16 * MiB;
constexpr size_t WS_U = 48 * MiB;
constexpr size_t WS_MIXIN = 96 * MiB;
constexpr size_t WS_MIX = 128 * MiB;
constexpr size_t WS_X1 = WS_MIXIN;
constexpr size_t WS_H2 = 160 * MiB;
constexpr size_t WS_W1 = 192 * MiB;
constexpr size_t WS_W2 = 320 * MiB;
constexpr size_t WS_ACT = 384 * MiB;
constexpr size_t WS_Y = 528 * MiB;
constexpr size_t WS_YSC = 608 * MiB;
constexpr size_t WS_END = 672 * MiB;
constexpr int CW_TMO = 0, CW_BAR = 4096, CW_CNT = 8192;

constexpr int RING_BYTES = 131072;
constexpr int AUX_OFF = 131072;
constexpr int LDSCTL_OFF = 143360;
constexpr int LDS_BYTES = 147456;

#define RLX_AGENT __ATOMIC_RELAXED, __HIP_MEMORY_SCOPE_AGENT
#define LDS_WAIT() asm volatile("s_waitcnt lgkmcnt(0)" ::: "memory")
#define VM_WAIT() asm volatile("s_waitcnt vmcnt(0)" ::: "memory")

__device__ __forceinline__ unsigned pk2(float lo, float hi) { bf16v2 v; v.x = (__bf16)lo; v.y = (__bf16)hi; return __builtin_bit_cast(unsigned, v); }
__device__ __forceinline__ unsigned pk4_fp8(float a, float b, float c, float d) {
    a = __builtin_amdgcn_fmed3f(a, -448.0f, 448.0f); b = __builtin_amdgcn_fmed3f(b, -448.0f, 448.0f); c = __builtin_amdgcn_fmed3f(c, -448.0f, 448.0f); d = __builtin_amdgcn_fmed3f(d, -448.0f, 448.0f);
    int w = 0; w = __builtin_amdgcn_cvt_pk_fp8_f32(a, b, w, false); w = __builtin_amdgcn_cvt_pk_fp8_f32(c, d, w, true); return (unsigned)w; }
__device__ __forceinline__ unsigned pk4_fp8_nosat(float a, float b, float c, float d) { int w = 0; w = __builtin_amdgcn_cvt_pk_fp8_f32(a, b, w, false); w = __builtin_amdgcn_cvt_pk_fp8_f32(c, d, w, true); return (unsigned)w; }
__device__ __forceinline__ float bf_lo(unsigned w) { return __uint_as_float(w << 16); }
__device__ __forceinline__ float bf_hi(unsigned w) { return __uint_as_float(w & 0xffff0000u); }
__device__ __forceinline__ float wave_sum(float v) {
#pragma unroll
    for (int o = 1; o < 64; o <<= 1) v += __shfl_xor(v, o);
    return v;
}
__device__ __forceinline__ float fast_sigmoid(float z) { return __builtin_amdgcn_rcpf(1.0f + __builtin_amdgcn_exp2f(-z * LOG2E)); }
__device__ __forceinline__ float gelu_tanh(float x) {
    const float u = 0.7978845608028654f * (x + 0.044715f * x * x * x);
    const float e = __builtin_amdgcn_exp2f(2.0f * LOG2E * u);
    return x - x * __builtin_amdgcn_rcpf(e + 1.0f);
}

#define XB_TMO      128
#define XB_XCNT(j)  (256  + 64 * (j))
#define XB_XSUB(j)  (1280 + 64 * (j))
#define XB_XGEN(j)  (2304 + 64 * (j))
#define XB_TOP      3328
#define XB_TOPGEN   3392
#define XCD_BAR_WORDS 3456
#define XB_SPIN_CAP (1u << 18)
__device__ __forceinline__ unsigned xb_ld(unsigned* p)              { return __hip_atomic_load(p, __ATOMIC_RELAXED, __HIP_MEMORY_SCOPE_AGENT); }
__device__ __forceinline__ unsigned xb_add(unsigned* p, unsigned v) { return __hip_atomic_fetch_add(p, v, __ATOMIC_RELAXED, __HIP_MEMORY_SCOPE_AGENT); }
__device__ __forceinline__ unsigned xb_xcc_id() { return (unsigned)__builtin_amdgcn_s_getreg((3 << 11) | 20) & 0xFu; }
#define XB_SPIN(cond, bar) do { unsigned _sp = 0; while (cond) { __builtin_amdgcn_s_sleep(1); \
    if ((++_sp & 255u) == 0u) { if (xb_ld(&(bar)[XB_TMO])) break; if (_sp > XB_SPIN_CAP) { atomicAdd(&(bar)[XB_TMO], 1u); break; } } } } while (0)
struct XcdBarrier { unsigned* bar; unsigned x; volatile LAS unsigned* st; };
__device__ __forceinline__ XcdBarrier xcd_barrier_post(unsigned* bar, volatile LAS unsigned* st) {
    XcdBarrier b; b.bar = bar; b.x = xb_xcc_id(); b.st = st;
    if (threadIdx.x == 0) (void)xb_add(&bar[XB_XCNT(b.x)], 1u);
    return b;
}
__device__ __forceinline__ void xcd_barrier_complete(unsigned* bar, unsigned x, unsigned& nloc, unsigned& nx) {
    const unsigned G = gridDim.x * gridDim.y * gridDim.z;
    unsigned sum, cnt, mine, sp = 0u;
    for (;;) {
        sum = 0u; cnt = 0u; mine = 0u;
#pragma unroll
        for (unsigned j = 0; j < 16; ++j) { const unsigned c = xb_ld(&bar[XB_XCNT(j)]); sum += c; cnt += (c > 0u) ? 1u : 0u; mine = (j == x) ? c : mine; }
        if (sum == G) break;
        __builtin_amdgcn_s_sleep(1);
        if ((++sp & 255u) == 0u) { if (xb_ld(&bar[XB_TMO])) break; if (sp > XB_SPIN_CAP) { atomicAdd(&bar[XB_TMO], 1u); break; } }
    }
    nloc = mine > 0u ? mine : 1u; nx = cnt > 0u ? cnt : 1u;
}
__device__ __forceinline__ void xcd_barrier(const XcdBarrier& b) {
    asm volatile("s_waitcnt vmcnt(0)" ::: "memory");
    __syncthreads();
    if (threadIdx.x == 0) {
        unsigned* bar = b.bar;
        __builtin_amdgcn_s_waitcnt(0);
        unsigned nloc = b.st[0], nx = b.st[1];
        if (nloc == 0u) { xcd_barrier_complete(bar, b.x, nloc, nx); b.st[0] = nloc; b.st[1] = nx; }
        const unsigned old = xb_add(&bar[XB_XSUB(b.x)], 1u);
        const unsigned gen = old / nloc;
        if (old + 1u == (gen + 1u) * nloc) {
            __builtin_amdgcn_fence(__ATOMIC_RELEASE, "agent");
            asm volatile("s_waitcnt vmcnt(0)" ::: "memory");
            const unsigned og = xb_add(&bar[XB_TOP], 1u);
            const unsigned tg = og / nx;
            if (og + 1u == (tg + 1u) * nx) xb_add(&bar[XB_TOPGEN], 1u);
            else XB_SPIN(xb_ld(&bar[XB_TOPGEN]) == tg, bar);
            __builtin_amdgcn_fence(__ATOMIC_ACQUIRE, "agent");
            xb_add(&bar[XB_XGEN(b.x)], 1u);
            asm volatile("s_waitcnt vmcnt(0)" ::: "memory");
        } else {
            XB_SPIN(xb_ld(&bar[XB_XGEN(b.x)]) == gen, bar);
            __builtin_amdgcn_fence(__ATOMIC_ACQUIRE, "agent");
            asm volatile("s_waitcnt vmcnt(0)" ::: "memory");
        }
    }
    __syncthreads();
}

namespace pg8 {
constexpr int BM = 256, BK = 64, HALF = 128, HTB = HALF * BK * 2, STAGE_BYTES = 8 * HTB, NXCD = 8, WGM = 8;
__device__ __forceinline__ int lds_byte(int r, int c) { const int st = (r >> 4) * 2 + (c >> 5), rr = r & 15, cc = c & 31, ob = rr * 64 + cc * 2; return st * 1024 + (ob ^ (((ob >> 9) & 1) << 5)); }
__device__ __forceinline__ void stage_rc(int b, int& R, int& C) { const int st = b / 1024, sb = b % 1024, swz = sb ^ (((sb >> 9) & 1) << 5); R = (st >> 1) * 16 + swz / 64; C = (st & 1) * 32 + (swz % 64) / 2; }
__device__ __forceinline__ int perm32(int rho) { const int n = rho >> 4, i = rho & 15; return 8 * (i >> 2) + 4 * n + (i & 3); }

struct Unit { int row0, col0, e, mt; };

struct StaticSched {
    const char* Bt; int K, nM, nN, nwg, G, c;
    __device__ __forceinline__ void init(const void* Bt_, int M, int N, int K_, int G_, int c_) { Bt = (const char*)Bt_; K = K_; nM = M / BM; nN = N / BM; nwg = nM * nN; G = G_; c = c_; }
    __device__ __forceinline__ bool next(int i, Unit& u) const {
        const long L = (long)i * G + c; if (L >= nwg) return false;
        int wgid = (int)L; { const int q = nwg / NXCD, r = nwg % NXCD, xcd = wgid % NXCD, off = wgid / NXCD; wgid = (xcd < r ? xcd * (q + 1) : r * (q + 1) + (xcd - r) * q) + off; }
        const int nig = WGM * nN, gid = wgid / nig, fm = gid * WGM, gsz = (nM - fm) < WGM ? (nM - fm) : WGM;
        u.row0 = BM * (fm + ((wgid % nig) % gsz)); u.col0 = BM * ((wgid % nig) / gsz); u.e = 0; u.mt = 0; return true;
    }
    __device__ __forceinline__ const char* b_base(const Unit& u) const { return Bt + (size_t)u.col0 * K * 2; }
    __device__ __forceinline__ void a_off(const Unit& u, const int (&R)[2], const int (&C)[2], unsigned (&off)[2][2]) const {
#pragma unroll
        for (int h = 0; h < 2; ++h)
#pragma unroll
            for (int i = 0; i < 2; ++i) off[h][i] = (unsigned)((u.row0 + HALF * h + R[i]) * K + C[i]) * 2u;
    }
};
template <bool GATHER> struct MoeSched {
    const char* Bt; size_t estride; LAS const int* tab; LAS const int* cnt; const int* list; int nunits;
    __device__ __forceinline__ bool next(int i, Unit& u) const {
        if (i >= nunits) return false;
        u.e = __builtin_amdgcn_readfirstlane(tab[4 * i + 0]); u.mt = __builtin_amdgcn_readfirstlane(tab[4 * i + 1]);
        u.row0 = BM * __builtin_amdgcn_readfirstlane(tab[4 * i + 2]); u.col0 = BM * __builtin_amdgcn_readfirstlane(tab[4 * i + 3]); return true;
    }
    __device__ __forceinline__ const char* b_base(const Unit& u) const { return Bt + (size_t)u.e * estride + (size_t)u.col0 * 1024; }
    __device__ __forceinline__ void a_off(const Unit& u, const int (&R)[2], const int (&C)[2], unsigned (&off)[2][2]) const {
        if constexpr (GATHER) {
            const int n = cnt[u.e]; const int* lp = list + (size_t)u.e * LISTCAP;
#pragma unroll
            for (int h = 0; h < 2; ++h)
#pragma unroll
                for (int i = 0; i < 2; ++i) { int r = BM * u.mt + HALF * h + R[i]; r = r < n ? r : n - 1; const int tok = lp[r]; off[h][i] = (unsigned)(tok * 512 + C[i]) * 2u; }
        } else {
#pragma unroll
            for (int h = 0; h < 2; ++h)
#pragma unroll
                for (int i = 0; i < 2; ++i) off[h][i] = (unsigned)((u.row0 + HALF * h + R[i]) * 512 + C[i]) * 2u;
        }
    }
};

struct EpiBf16 {
    static constexpr int PERM = 1; static constexpr bool F8 = false;
    bf16* O; int ldc; const float* bias; int bias_estride;
    __device__ __forceinline__ void operator()(const f32x4 (&acc)[2][2][4][2], const Unit& u, int wr, int wc, int fr, int fq) const {
        const int row0 = u.row0 + wr * 64 + fr, col0 = u.col0 + wc * 32 + 8 * fq;
        f32x4 bv[2][2];
#pragma unroll
        for (int bj = 0; bj < 2; ++bj)
#pragma unroll
            for (int n = 0; n < 2; ++n) bv[bj][n] = bias ? *(const f32x4*)(bias + (size_t)u.e * bias_estride + col0 + bj * HALF + 4 * n) : (f32x4){0.f, 0.f, 0.f, 0.f};
#pragma unroll
        for (int ai = 0; ai < 2; ++ai)
#pragma unroll
            for (int m = 0; m < 4; ++m) { bf16* rowp = O + (size_t)(row0 + ai * HALF + m * 16) * ldc + col0;
#pragma unroll
                for (int bj = 0; bj < 2; ++bj) { const f32x4 v0 = acc[ai][bj][m][0] + bv[bj][0], v1 = acc[ai][bj][m][1] + bv[bj][1];
                    v4u w; w.x = pk2(v0[0], v0[1]); w.y = pk2(v0[2], v0[3]); w.z = pk2(v1[0], v1[1]); w.w = pk2(v1[2], v1[3]);
                    *(v4u*)(rowp + bj * HALF) = w; } }
    }
};
struct EpiSwiglu8 {
    static constexpr int PERM = 0; static constexpr bool F8 = true;
    unsigned char* O; const float* b1; const float* sW; const float* scl; LAS const int* cnt;
    __device__ __forceinline__ void operator()(const f32x4 (&acc)[2][2][4][2], const Unit& u, int wr, int wc, int fr, int fq) const {
        const int row0 = u.row0 + wr * 64 + fr, rank0 = BM * u.mt + wr * 64 + fr, n = cnt[u.e];
        const int j0 = (u.col0 >> 1) + 16 * wc + 4 * fq;
        f32x2 bg[2][2], bl[2][2]; float sg[2];
#pragma unroll
        for (int bj = 0; bj < 2; ++bj) { const float* bp = b1 + (size_t)u.e * DE2 + 2 * (j0 + 64 * bj); const f32x4 p = *(const f32x4*)bp, q = *(const f32x4*)(bp + 4);
            bg[bj][0] = (f32x2){p[0], p[2]}; bg[bj][1] = (f32x2){q[0], q[2]}; bl[bj][0] = (f32x2){p[1], p[3]}; bl[bj][1] = (f32x2){q[1], q[3]};
            sg[bj] = sW[u.e * 64 + ((u.col0 + 128 * bj) >> 5) + wc]; }
        float sa[2][4];
#pragma unroll
        for (int ai = 0; ai < 2; ++ai)
#pragma unroll
            for (int m = 0; m < 4; ++m) { const int rk = rank0 + ai * HALF + m * 16; sa[ai][m] = rk < n ? scl[(size_t)u.e * LISTCAP + rk] : 0.f; }
#pragma unroll
        for (int ai = 0; ai < 2; ++ai)
#pragma unroll
            for (int m = 0; m < 4; ++m) { unsigned char* rowp = O + (size_t)(row0 + ai * HALF + m * 16) * 1024 + j0;
#pragma unroll
                for (int bj = 0; bj < 2; ++bj) { const float sc = sa[ai][m] * sg[bj]; float o[4];
#pragma unroll
                    for (int hx = 0; hx < 2; ++hx) {
                        const f32x2 ga = {acc[ai][bj][m][0][2 * hx], acc[ai][bj][m][0][2 * hx + 1]}, la = {acc[ai][bj][m][1][2 * hx], acc[ai][bj][m][1][2 * hx + 1]};
                        f32x2 g = ga * sc + bg[bj][hx], l = la * sc + bl[bj][hx];
                        g.x = fminf(g.x, 7.0f); g.y = fminf(g.y, 7.0f); l.x = __builtin_amdgcn_fmed3f(l.x, -7.0f, 7.0f); l.y = __builtin_amdgcn_fmed3f(l.y, -7.0f, 7.0f);
                        const f32x2 z = g * (-1.702f * LOG2E); f32x2 e; e.x = __builtin_amdgcn_exp2f(z.x); e.y = __builtin_amdgcn_exp2f(z.y);
                        const f32x2 d = e + 1.0f; f32x2 r; r.x = __builtin_amdgcn_rcpf(d.x); r.y = __builtin_amdgcn_rcpf(d.y);
                        const f32x2 ov = (g * r) * (l * 8.0f + 8.0f);
                        o[2 * hx] = ov.x; o[2 * hx + 1] = ov.y; }
                    *(unsigned*)(rowp + bj * 64) = pk4_fp8_nosat(o[0], o[1], o[2], o[3]); } }
    }
};
struct EpiY8 {
    static constexpr int PERM = 2; static constexpr bool F8 = true;
    unsigned char* O; float* osc; const float* bias; const float* sW;
    __device__ __forceinline__ void operator()(const f32x4 (&acc)[2][2][4][2], const Unit& u, int wr, int wc, int fr, int fq) const {
        const int row0 = u.row0 + wr * 64 + fr, col0 = u.col0 + 64 * wc + 16 * fq;
        f32x4 bv[2][2];
#pragma unroll
        for (int bj = 0; bj < 2; ++bj)
#pragma unroll
            for (int n = 0; n < 2; ++n) bv[bj][n] = *(const f32x4*)(bias + (size_t)u.e * D + col0 + 8 * bj + 4 * n);
        const float s1 = sW[u.e * 32 + (col0 >> 5)] * 0.125f;
#pragma unroll
        for (int ai = 0; ai < 2; ++ai)
#pragma unroll
            for (int m = 0; m < 4; ++m) { const int row = row0 + ai * HALF + m * 16;
                f32x4 v[2][2]; float am = 0.f;
#pragma unroll
                for (int bj = 0; bj < 2; ++bj)
#pragma unroll
                    for (int n = 0; n < 2; ++n) { v[bj][n] = acc[ai][bj][m][n] * s1 + bv[bj][n];
                        am = fmaxf(fmaxf(am, fmaxf(fabsf(v[bj][n][0]), fabsf(v[bj][n][1]))), fmaxf(fabsf(v[bj][n][2]), fabsf(v[bj][n][3]))); }
                am = fmaxf(am, __shfl_xor(am, 16)); am = fmaxf(am, __shfl_xor(am, 32));
                const float sc = am > 0.f ? am * (1.0f / 448.0f) : 1.0f, iv = 1.0f / sc;
                v4u w;
                w.x = pk4_fp8(v[0][0][0] * iv, v[0][0][1] * iv, v[0][0][2] * iv, v[0][0][3] * iv); w.y = pk4_fp8(v[0][1][0] * iv, v[0][1][1] * iv, v[0][1][2] * iv, v[0][1][3] * iv);
                w.z = pk4_fp8(v[1][0][0] * iv, v[1][0][1] * iv, v[1][0][2] * iv, v[1][0][3] * iv); w.w = pk4_fp8(v[1][1][0] * iv, v[1][1][1] * iv, v[1][1][2] * iv, v[1][1][3] * iv);
                *(v4u*)(O + (size_t)row * 1024 + col0) = w;
                if (fq == 0) osc[(size_t)row * 16 + (u.col0 >> 6) + wc] = sc; }
    }
};

template <class Epi, class Sched>
__device__ __forceinline__ void gemm_phase(LAS unsigned char* lds, const char* Abase, const int K, const Sched& S, const Epi& E) {
    const int tid = threadIdx.x, wid = __builtin_amdgcn_readfirstlane(tid >> 6), lane = tid & 63, wr = wid >> 2, wc = wid & 3, fr = lane & 15, fq = lane >> 4;
    const int nt = K / BK;
    int R[2], C[2]; unsigned voffB[2][2];
#pragma unroll
    for (int i = 0; i < 2; ++i) { stage_rc(tid * 16 + i * 8192, R[i], C[i]);
#pragma unroll
        for (int bj = 0; bj < 2; ++bj) { int Rb;
            if (Epi::PERM == 2) Rb = 64 * (R[i] >> 5) + 16 * ((R[i] & 15) >> 2) + 8 * bj + 4 * ((R[i] >> 4) & 1) + (R[i] & 3);
            else Rb = HALF * bj + (Epi::PERM == 1 ? ((R[i] & ~31) + perm32(R[i] & 31)) : R[i]);
            voffB[bj][i] = (unsigned)(Rb * K + C[i]) * 2u; } }
    const size_t kstep = (size_t)(BK * 2);
    const size_t hstep = (size_t)HALF * K * 2;
    const unsigned ldsw = (unsigned)wid * 1024u;
    const int aoff = lds_byte(wr * 64 + fr, fq * 8), boff = lds_byte(wc * 32 + fr, fq * 8);
#define PG8_SA(b, h) (((b) * 2 + (h)) * HTB)
#define PG8_SB(b, h) ((4 + (b) * 2 + (h)) * HTB)
#define PG8_STAGEB(bufoff, gbase, bj_) do { _Pragma("unroll") for (int _i = 0; _i < 2; ++_i) \
        __builtin_amdgcn_global_load_lds((const unsigned*)((const char*)(gbase) + voffB[bj_][_i]), (LAS unsigned*)(lds + (bufoff) + ldsw + _i * 8192), 16, 0, 0); } while (0)
#define PG8_STAGEA(bufoff, o, h, kb) do { _Pragma("unroll") for (int _i = 0; _i < 2; ++_i) \
        __builtin_amdgcn_global_load_lds((const unsigned*)(Abase + (size_t)(o)[h][_i] + (size_t)(kb)), (LAS unsigned*)(lds + (bufoff) + ldsw + _i * 8192), 16, 0, 0); } while (0)
#define PG8_LDA(dst, b, h) do { _Pragma("unroll") for (int m = 0; m < 4; ++m) _Pragma("unroll") for (int k = 0; k < 2; ++k) dst[m][k] = *(const LAS bf16x8*)(lds + PG8_SA(b, h) + aoff + m * 2048 + k * 1024); } while (0)
#define PG8_LDB(dst, b, h) do { _Pragma("unroll") for (int n = 0; n < 2; ++n) _Pragma("unroll") for (int k = 0; k < 2; ++k) dst[n][k] = *(const LAS bf16x8*)(lds + PG8_SB(b, h) + boff + n * 2048 + k * 1024); } while (0)
#define PG8_CAT(f) __builtin_shufflevector(__builtin_bit_cast(v4i, (f)[0]), __builtin_bit_cast(v4i, (f)[1]), 0, 1, 2, 3, 4, 5, 6, 7)
#define PG8_MMA(ai, bj, At, Bt) do { __builtin_amdgcn_s_setprio(1); _Pragma("unroll") for (int m = 0; m < 4; ++m) _Pragma("unroll") for (int n = 0; n < 2; ++n) { \
        if constexpr (Epi::F8) { const v8i _b = PG8_CAT(Bt[n]), _a = PG8_CAT(At[m]); asm volatile("v_mfma_scale_f32_16x16x128_f8f6f4 %0, %1, %2, %0, %3, %3 op_sel_hi:[0,0,0]" : "+v"(acc[ai][bj][m][n]) : "v"(_b), "v"(_a), "v"(one8)); } \
        else { _Pragma("unroll") for (int k = 0; k < 2; ++k) acc[ai][bj][m][n] = __builtin_amdgcn_mfma_f32_16x16x32_bf16(Bt[n][k], At[m][k], acc[ai][bj][m][n], 0, 0, 0); } } __builtin_amdgcn_s_setprio(0); } while (0)
#define PG8_WAIT_V(n) asm volatile("s_waitcnt vmcnt(" #n ")" ::: "memory")
#define PG8_WAIT_L(n) asm volatile("s_waitcnt lgkmcnt(" #n ")" ::: "memory")
#define PG8_BAR __builtin_amdgcn_s_barrier()
#define PG8_SCHED __builtin_amdgcn_sched_barrier(0)
    Unit cur, nxt; int ui = 0;
    if (!S.next(0, cur)) return;
    int one8 = 0x7f7f7f7f; asm volatile("" : "+v"(one8));
    f32x4 acc[2][2][4][2];
#pragma unroll
    for (int a = 0; a < 2; ++a)
#pragma unroll
        for (int b = 0; b < 2; ++b)
#pragma unroll
            for (int m = 0; m < 4; ++m)
#pragma unroll
                for (int n = 0; n < 2; ++n) acc[a][b][m][n] = (f32x4){0.f, 0.f, 0.f, 0.f};
    bf16x8 At[4][2], B0[2][2], B1[2][2];
    unsigned offA[2][2], offN[2][2];
    S.a_off(cur, R, C, offA);
    const char* cB = S.b_base(cur);
    PG8_STAGEB(PG8_SB(0, 0), cB, 0); PG8_STAGEB(PG8_SB(0, 1), cB, 1); PG8_STAGEA(PG8_SA(0, 0), offA, 0, 0); PG8_STAGEA(PG8_SA(0, 1), offA, 1, 0);
    if (wr == 1) PG8_BAR;
    PG8_WAIT_V(2); PG8_BAR;
    PG8_STAGEB(PG8_SB(1, 0), cB + kstep, 0); PG8_STAGEA(PG8_SA(1, 0), offA, 0, kstep); PG8_STAGEB(PG8_SB(1, 1), cB + kstep, 1);
    PG8_WAIT_V(6); PG8_BAR;
    for (;;) {
        const bool has_next = S.next(ui + 1, nxt);
        const char* nB = has_next ? S.b_base(nxt) : cB;
        if (has_next) { S.a_off(nxt, R, C, offN); } else {
#pragma unroll
            for (int h = 0; h < 2; ++h)
#pragma unroll
                for (int i = 0; i < 2; ++i) offN[h][i] = offA[h][i]; }
        asm volatile("" : "+v"(offN[0][0]), "+v"(offN[0][1]), "+v"(offN[1][0]), "+v"(offN[1][1]));
#pragma unroll 1
        for (int t = 0; t < nt; t += 2) {
            const bool last = (t == nt - 2);
            const size_t k1 = (size_t)(t + 1) * kstep;
            const size_t k2 = last ? 0 : (size_t)(t + 2) * kstep, k3 = k2 + kstep;
            const char* b2 = last ? nB : cB + (size_t)(t + 2) * kstep; const char* b3 = b2 + kstep;
            unsigned o2[2][2];
#pragma unroll
            for (int h = 0; h < 2; ++h)
#pragma unroll
                for (int i = 0; i < 2; ++i) o2[h][i] = last ? offN[h][i] : offA[h][i];
            PG8_LDB(B0, 0, 0); PG8_LDB(B1, 0, 1); PG8_SCHED; PG8_LDA(At, 0, 0); PG8_STAGEA(PG8_SA(1, 1), offA, 1, k1);
            PG8_WAIT_V(8); PG8_WAIT_L(0); PG8_BAR; PG8_MMA(0, 0, At, B0); PG8_MMA(0, 1, At, B1); PG8_BAR; PG8_SCHED;
            PG8_LDA(At, 0, 1); PG8_STAGEB(PG8_SB(0, 0), b2, 0); PG8_STAGEB(PG8_SB(0, 1), b2, 1); PG8_STAGEA(PG8_SA(0, 0), o2, 0, k2);
            PG8_WAIT_V(8); PG8_WAIT_L(0); PG8_BAR; PG8_MMA(1, 0, At, B0); PG8_MMA(1, 1, At, B1); PG8_BAR; PG8_SCHED;
            PG8_LDB(B0, 1, 0); PG8_LDB(B1, 1, 1); PG8_SCHED; PG8_LDA(At, 1, 0); PG8_STAGEA(PG8_SA(0, 1), o2, 1, k2);
            PG8_WAIT_V(8); PG8_WAIT_L(0); PG8_BAR; PG8_MMA(0, 0, At, B0); PG8_MMA(0, 1, At, B1); PG8_BAR; PG8_SCHED;
            PG8_LDA(At, 1, 1); PG8_STAGEB(PG8_SB(1, 0), b3, 0); PG8_STAGEB(PG8_SB(1, 1), b3, 1); PG8_STAGEA(PG8_SA(1, 0), o2, 0, k3);
            PG8_WAIT_V(8); PG8_WAIT_L(0); PG8_BAR; PG8_MMA(1, 0, At, B0); PG8_MMA(1, 1, At, B1); PG8_BAR; PG8_SCHED;
        }
        if (wr == 0) PG8_BAR;
        if constexpr (Epi::F8) asm volatile("s_nop 15\n\ts_nop 7" ::: "memory");
        { int lz = lane; asm volatile("" : "+v"(lz));
          E(acc, cur, wr, wc, lz & 15, lz >> 4); }
        if (!has_next) break;
#pragma unroll
        for (int a = 0; a < 2; ++a)
#pragma unroll
            for (int b = 0; b < 2; ++b)
#pragma unroll
                for (int m = 0; m < 4; ++m)
#pragma unroll
                    for (int n = 0; n < 2; ++n) acc[a][b][m][n] = (f32x4){0.f, 0.f, 0.f, 0.f};
        cur = nxt; cB = nB; ++ui;
#pragma unroll
        for (int h = 0; h < 2; ++h)
#pragma unroll
            for (int i = 0; i < 2; ++i) offA[h][i] = offN[h][i];
        if (wr == 1) PG8_BAR;
    }
    PG8_WAIT_V(0);
    PG8_BAR;
#undef PG8_SA
#undef PG8_SB
#undef PG8_STAGEA
#undef PG8_STAGEB
#undef PG8_LDA
#undef PG8_LDB
#undef PG8_MMA
#undef PG8_CAT
#undef PG8_WAIT_V
#undef PG8_WAIT_L
#undef PG8_BAR
#undef PG8_SCHED
}
}

struct Frame {
    LAS unsigned char* lds;
    gu32* ctl; unsigned char* ws;
    int tid, lane, wave, vcu, G;
    const float *x, *c, *w_ada, *b_ada, *g_mix_pre, *g_mix_post, *w_in, *conv_w, *conv_b, *gaw, *gab, *gxw, *gxb, *lam, *pool_w, *pool_b, *pool_s, *w_out,
                *g_ffn_pre, *g_ffn_post, *router_w, *router_b, *w1, *b1, *w2, *b2;
    float* out; float* out2;
    float *modp, *CT, *gate, *sW1, *sW2, *scl; bf16 *GT, *WIN, *WOUT, *H, *U, *MIXIN, *MIX, *X1; unsigned char* Y; float* YSC; unsigned char *H2, *W1T, *W2T, *ACT; unsigned* slot; int* list;
};
__device__ __forceinline__ float modv(const Frame& F, int b, int n) {
    const float* p = F.modp + b * 6144 + n;
    return ((p[0] + p[4 * 6144]) + (p[8 * 6144] + p[12 * 6144])) + F.b_ada[n];
}

struct TrJob { const float* W; bf16* WT; int ldn, nblk, K, mode; };
__device__ __forceinline__ void tr_load(const TrJob& j, int item, int lane, f32x4 (&v)[8]) {
    const int kb = item / j.nblk, nb = item % j.nblk; const float* p = j.W + (size_t)(64 * kb + (lane >> 3)) * j.ldn + 32 * nb + 4 * (lane & 7);
#pragma unroll
    for (int i = 0; i < 8; ++i) v[i] = *(const f32x4*)(p + (size_t)(8 * i) * j.ldn);
}
__device__ __forceinline__ void tr_put(LAS float* scr, int lane, const f32x4 (&v)[8]) {
#pragma unroll
    for (int i = 0; i < 8; ++i) { LAS float* s = scr + (8 * i + (lane >> 3)) * 33 + 4 * (lane & 7); s[0] = v[i][0]; s[1] = v[i][1]; s[2] = v[i][2]; s[3] = v[i][3]; }
}
__device__ __forceinline__ void tr_store(const TrJob& j, int item, int lane, LAS const float* scr) {
    const int kb = item / j.nblk, nb = item % j.nblk, k0 = 64 * kb, n0 = 32 * nb, c = lane & 7;
#pragma unroll
    for (int q = 0; q < 4; ++q) { const int n = (lane >> 3) + 8 * q; LAS const float* s = scr + (8 * c) * 33 + n;
        v4u o; o.x = pk2(s[0 * 33], s[1 * 33]); o.y = pk2(s[2 * 33], s[3 * 33]); o.z = pk2(s[4 * 33], s[5 * 33]); o.w = pk2(s[6 * 33], s[7 * 33]);
        const int orow = j.mode ? n0 + ((n & 1) ? 16 + (n >> 1) : (n >> 1)) : n0 + n;
        *(v4u*)(j.WT + (size_t)orow * j.K + k0 + 8 * c) = o; }
}
__device__ __forceinline__ bool tr_job(const Frame& F, int it, TrJob& j, int& item) {
    constexpr int I_IN = 16 * 32, I_OUT = 16 * 32;
    if (it < I_IN) { j = TrJob{F.w_in, F.WIN, INW, 32, D, 0}; item = it; return true; } it -= I_IN;
    if (it < I_OUT) { j = TrJob{F.w_out, F.WOUT, D, 32, D, 0}; item = it; return true; }
    return false;
}
__device__ __forceinline__ void strip_job(const Frame& F, int s, const float*& W, unsigned char*& WT, float*& SW, int& ldn, int& mode) {
    const bool is1 = s < 2048; const int s2 = is1 ? s : s - 2048; const int e = is1 ? (s2 >> 6) : (s2 >> 5), nb = is1 ? (s2 & 63) : (s2 & 31);
    const int rows = is1 ? DE2 : D;
    const size_t r0 = (size_t)e * rows + 32 * nb;
    const long d21 = F.w2 - F.w1;
    W = F.w1 + (is1 ? 0l : d21) + (size_t)e * D * rows + 32 * nb;
    WT = F.ws + (is1 ? WS_W1 : WS_W2) + r0 * 1024;
    SW = (float*)(F.ws + (is1 ? WS_SW1 : WS_SW2)) + (is1 ? e * 64 + nb : e * 32 + nb);
    ldn = rows; mode = is1 ? 1 : 0;
}
__device__ __forceinline__ void strip_load(const float* W, int ldn, int wave, int lane, f32x4 (&v)[16]) {
    const float* p = W + (size_t)(128 * wave + (lane >> 3)) * ldn + 4 * (lane & 7);
#pragma unroll
    for (int i = 0; i < 16; ++i) v[i] = *(const f32x4*)(p + (size_t)(8 * i) * ldn);
}
template <int PROBE, bool PRE> __device__ __forceinline__ void p0_strips(Frame& F, int first, int step, int last, f32x4 (&va)[16]) {
    const int lane = F.lane;
    {
        const int w = F.wave;
        LAS float* scr = (LAS float*)(F.lds + w * 16896);
        LAS float* pm = (LAS float*)(F.lds + 8 * 16896);
        const int NSTRIPS = last;
        f32x4 vb[16];
        int par = 0;
#define STRIP_ISSUE(v, sidx) do { if ((sidx) < NSTRIPS) { const float* _W; unsigned char* _WT; float* _SW; int _ldn, _mode; strip_job(F, (sidx), _W, _WT, _SW, _ldn, _mode); strip_load(_W, _ldn, w, lane, v); } } while (0)
#define STRIP_PROCESS(v, sidx, nextv, nextidx) do { \
            unsigned char* cWT; float* cSW; int cmode; { const float* _W; int _ldn; strip_job(F, (sidx), _W, cWT, cSW, _ldn, cmode); } \
            f32x4 mx = {0.f, 0.f, 0.f, 0.f}; \
            _Pragma("unroll") for (int i = 0; i < 16; ++i) { LAS float* sp = scr + (8 * i + (lane >> 3)) * 33 + 4 * (lane & 7); sp[0] = v[i][0]; sp[1] = v[i][1]; sp[2] = v[i][2]; sp[3] = v[i][3]; \
                mx[0] = fmaxf(mx[0], fabsf(v[i][0])); mx[1] = fmaxf(mx[1], fabsf(v[i][1])); mx[2] = fmaxf(mx[2], fabsf(v[i][2])); mx[3] = fmaxf(mx[3], fabsf(v[i][3])); } \
            _Pragma("unroll") for (int x = 0; x < 4; ++x) { float m = mx[x]; m = fmaxf(m, __shfl_xor(m, 8)); m = fmaxf(m, __shfl_xor(m, 16)); m = fmaxf(m, __shfl_xor(m, 32)); mx[x] = m; } \
            if (lane < 8) *(LAS f32x4*)(pm + (par * 8 + w) * 32 + 4 * lane) = mx; \
            STRIP_ISSUE(nextv, nextidx); \
            asm volatile("s_waitcnt lgkmcnt(0)" ::: "memory"); __builtin_amdgcn_s_barrier(); asm volatile("" ::: "memory"); \
            float inv[2]; \
            { const f32x4 p4 = *(LAS const f32x4*)(pm + par * 256 + 4 * lane); float am = fmaxf(fmaxf(p4[0], p4[1]), fmaxf(p4[2], p4[3])); \
              _Pragma("unroll") for (int o_ = 1; o_ < 64; o_ <<= 1) am = fmaxf(am, __shfl_xor(am, o_)); \
              const float sc = am > 0.f ? am * (1.0f / 448.0f) : 1.0f; inv[0] = 1.0f / sc; inv[1] = inv[0]; \
              if (w == 0 && lane == 0) cSW[0] = sc; } \
            _Pragma("unroll") for (int tl = 0; tl < 2; ++tl) _Pragma("unroll") for (int jj = 0; jj < 2; ++jj) { const int n = (lane >> 2) + 16 * jj, c = lane & 3; LAS const float* sp = scr + (64 * tl + 16 * c) * 33 + n; const float iv = inv[jj]; \
                    v4u o; \
                    o.x = pk4_fp8(sp[0 * 33] * iv, sp[1 * 33] * iv, sp[2 * 33] * iv, sp[3 * 33] * iv); o.y = pk4_fp8(sp[4 * 33] * iv, sp[5 * 33] * iv, sp[6 * 33] * iv, sp[7 * 33] * iv); \
                    o.z = pk4_fp8(sp[8 * 33] * iv, sp[9 * 33] * iv, sp[10 * 33] * iv, sp[11 * 33] * iv); o.w = pk4_fp8(sp[12 * 33] * iv, sp[13 * 33] * iv, sp[14 * 33] * iv, sp[15 * 33] * iv); \
                    const int orow = cmode ? ((n & 1) ? 16 + (n >> 1) : (n >> 1)) : n; \
                    if (PROBE != 2) *(v4u*)(cWT + (PROBE ? (size_t)WS_END : (size_t)0) + (size_t)orow * 1024 + 128 * w + 64 * tl + 16 * c) = o; else if (o.x == 0x12345678u) *(v4u*)(cWT) = o; } \
            asm volatile("s_waitcnt lgkmcnt(0)" ::: "memory"); par ^= 1; } while (0)
        int st = first;
        if (!PRE) STRIP_ISSUE(va, st);
        STRIP_ISSUE(vb, st + step);
        while (st < NSTRIPS) {
            STRIP_PROCESS(va, st, va, st + 2 * step); st += step;
            if (st >= NSTRIPS) break;
            STRIP_PROCESS(vb, st, vb, st + 2 * step); st += step;
        }
#undef STRIP_ISSUE
#undef STRIP_PROCESS
    }
}
__device__ __forceinline__ void p0_prologue(Frame& F) {
    const int tid = F.tid, lane = F.lane;
    if (F.G == 256) {
        const int it = blockIdx.x, kq = it >> 6, nc = it & 63;
        const float ca0 = F.c[(tid >> 8) * D + 256 * kq + (tid & 255)], ca1 = F.c[((tid + 512) >> 8) * D + 256 * kq + (tid & 255)];
        const int c4 = tid % 24, kl = tid / 24;
        f32x4 wv[16];
        { const float* wp = F.w_ada + (size_t)(256 * kq + (tid < 384 ? kl : 0)) * 6144 + 96 * nc + 4 * (tid < 384 ? c4 : 0);
#pragma unroll
          for (int j = 0; j < 16; ++j) wv[j] = *(const f32x4*)(wp + (size_t)(16 * j) * 6144); }
        float wb[4];
#pragma unroll
        for (int j = 0; j < 4; ++j) { const int i = tid + 512 * j; wb[j] = F.w_in[(size_t)(4 * it + (i >> 9)) * INW + 1024 + (i & 511)]; }
        const int gw = F.vcu * NWAVES + F.wave; TrJob tj; int titem = 0; f32x4 dv[8];
        const bool hasD = tr_job(F, gw < 1024 ? gw : 0, tj, titem) && gw < 1024;
        tr_load(tj, titem, lane, dv);
        const int gt = blockIdx.x * NTHREADS + tid; const bool hasG = gt < 64 * 17 * 64;
        const int gl = gt & 63, gs = (gt >> 6) % 17, gun = hasG ? gt / (64 * 17) : 0, gh = gun >> 3, go = gun & 7, gm = gl & 31, gk0 = 8 * (gl >> 5);
        float cwv[8], gvv[8];
#pragma unroll
        for (int jj = 0; jj < 8; ++jj) { const int i = 16 * (gs & 3) + gk0 + jj, tap = (gs < 16) ? (gs >> 2) : 0; cwv[jj] = F.conv_w[tap * LRU + 64 * gh + i];
            const float* gp = (gm < 8 ? F.gaw : F.gxw) + (size_t)(gh * 64 + i) * 64 + 8 * go + (gm & 7); gvv[jj] = *gp; }
        const int cch = blockIdx.x * NWAVES + F.wave; const bool hasC = cch < LRU; const int chh = hasC ? (cch >> 6) : 0, cjn = cch & 63;
        const float ccb = F.conv_b[64 * chh + lane], cga = F.gaw[(size_t)(chh * 64 + lane) * 64 + cjn], cgx = F.gxw[(size_t)(chh * 64 + lane) * 64 + cjn];
        f32x4 sva[16];
        if (F.vcu < NS_P0) { const float* sW_; unsigned char* sWT_; float* sSW_; int sldn_, smode_; strip_job(F, F.vcu, sW_, sWT_, sSW_, sldn_, smode_); strip_load(sW_, sldn_, F.wave, lane, sva); }
        LAS float* cact = (LAS float*)F.lds; LAS float* red = (LAS float*)(F.lds + 4096);
        cact[tid] = ca0 / (1.0f + __expf(-ca0)); cact[tid + 512] = ca1 / (1.0f + __expf(-ca1));
        __syncthreads();
        if (tid < 384) {
            f32x4 a0 = {0.f, 0.f, 0.f, 0.f}, a1 = a0, a2 = a0, a3 = a0;
#pragma unroll
            for (int j = 0; j < 16; ++j) { const int k = kl + 16 * j; a0 += cact[k] * wv[j]; a1 += cact[256 + k] * wv[j]; a2 += cact[512 + k] * wv[j]; a3 += cact[768 + k] * wv[j]; }
            *(LAS f32x4*)(red + (kl * 4 + 0) * 96 + 4 * c4) = a0; *(LAS f32x4*)(red + (kl * 4 + 1) * 96 + 4 * c4) = a1;
            *(LAS f32x4*)(red + (kl * 4 + 2) * 96 + 4 * c4) = a2; *(LAS f32x4*)(red + (kl * 4 + 3) * 96 + 4 * c4) = a3;
        }
        __syncthreads();
        if (tid < 384) { const int b = tid / 96, col = tid % 96; float sm = 0.f;
#pragma unroll
            for (int k2 = 0; k2 < 16; ++k2) sm += red[(k2 * 4 + b) * 96 + col];
            F.modp[(kq * 4 + b) * 6144 + 96 * nc + col] = sm; }
        __syncthreads();
        { LAS float* win = (LAS float*)F.lds;
#pragma unroll
          for (int j = 0; j < 4; ++j) win[tid + 512 * j] = wb[j];
          __syncthreads();
          const int g = tid >> 7, d = tid & 127; float a0 = 0.f, a1 = 0.f, a2 = 0.f, a3 = 0.f;
          const float* pw = F.pool_w + (size_t)g * 128 * 128 + d; LAS const float* wl = win + 128 * g;
#pragma unroll 16
          for (int cc = 0; cc < 128; ++cc) { const float p = pw[cc * 128]; a0 += wl[cc] * p; a1 += wl[512 + cc] * p; a2 += wl[1024 + cc] * p; a3 += wl[1536 + cc] * p; }
          v2u o; o.x = pk2(a0, a1); o.y = pk2(a2, a3);
          *(v2u*)(F.WIN + (size_t)(1024 + tid) * D + 4 * it) = o;
          __syncthreads(); }
        if (hasG) { float v[8];
#pragma unroll
            for (int jj = 0; jj < 8; ++jj) { const int kk = gk0 + jj; float val = 0.f;
                if (gs < 16) { const int i = 16 * (gs & 3) + kk; if (gm < 16) val = cwv[jj] * gvv[jj]; else if (gm < 24) val = (i == 8 * go + gm - 16) ? cwv[jj] : 0.f; }
                else if (gm >= 24) val = (kk == 8 * (go & 1) + gm - 24) ? 1.0f : 0.f;
                v[jj] = val; }
            v4u wq; wq.x = pk2(v[0], v[1]); wq.y = pk2(v[2], v[3]); wq.z = pk2(v[4], v[5]); wq.w = pk2(v[6], v[7]);
            *(v4u*)(F.GT + (size_t)gt * 8) = wq; }
        { const float sa = wave_sum(ccb * cga), sx = wave_sum(ccb * cgx);
          if (hasC && lane == 0) { const float lm = F.lam[cch]; const float sp = log1pf(__expf(-lm));
            f32x4 o; o[0] = sa + F.gab[cch]; o[1] = sx + F.gxb[cch]; o[2] = F.conv_b[cch]; o[3] = -8.0f * sp * LOG2E;
            *(f32x4*)(F.CT + 4 * cch) = o; } }
        if (hasD) { LAS float* scr = (LAS float*)(F.lds + F.wave * 8448);
            tr_put(scr, lane, dv); LDS_WAIT(); asm volatile("" ::: "memory");
            tr_store(tj, titem, lane, scr); LDS_WAIT(); asm volatile("" ::: "memory"); }
        __syncthreads();
        p0_strips<0, true>(F, F.vcu, F.G, NS_P0, sva);
        return;
    }
    for (int it = blockIdx.x; it < 256; it += F.G) {
        LAS float* cact = (LAS float*)F.lds; LAS float* red = (LAS float*)(F.lds + 4096);
        const int kq = it >> 6, nc = it & 63;
        for (int i = tid; i < 1024; i += NTHREADS) { const float cv = F.c[(i >> 8) * D + 256 * kq + (i & 255)]; cact[i] = cv / (1.0f + __expf(-cv)); }
        __syncthreads();
        if (tid < 384) {
            const int c4 = tid % 24, kl = tid / 24;
            f32x4 a0 = {0.f, 0.f, 0.f, 0.f}, a1 = a0, a2 = a0, a3 = a0;
            const float* wp = F.w_ada + (size_t)(256 * kq + kl) * 6144 + 96 * nc + 4 * c4;
            f32x4 wv[16];
#pragma unroll
            for (int j = 0; j < 16; ++j) wv[j] = *(const f32x4*)(wp + (size_t)(16 * j) * 6144);
#pragma unroll
            for (int j = 0; j < 16; ++j) { const int k = kl + 16 * j; a0 += cact[k] * wv[j]; a1 += cact[256 + k] * wv[j]; a2 += cact[512 + k] * wv[j]; a3 += cact[768 + k] * wv[j]; }
            *(LAS f32x4*)(red + (kl * 4 + 0) * 96 + 4 * c4) = a0; *(LAS f32x4*)(red + (kl * 4 + 1) * 96 + 4 * c4) = a1;
            *(LAS f32x4*)(red + (kl * 4 + 2) * 96 + 4 * c4) = a2; *(LAS f32x4*)(red + (kl * 4 + 3) * 96 + 4 * c4) = a3;
        }
        __syncthreads();
        if (tid < 384) { const int b = tid / 96, col = tid % 96; float s = 0.f;
#pragma unroll
            for (int kl = 0; kl < 16; ++kl) s += red[(kl * 4 + b) * 96 + col];
            F.modp[(kq * 4 + b) * 6144 + 96 * nc + col] = s; }
        __syncthreads();
    }
    for (int it = blockIdx.x; it < 256; it += F.G) {
        LAS float* win = (LAS float*)F.lds;
        for (int i = tid; i < 2048; i += NTHREADS) win[i] = F.w_in[(size_t)(4 * it + (i >> 9)) * INW + 1024 + (i & 511)];
        __syncthreads();
        { const int g = tid >> 7, d = tid & 127; float a0 = 0.f, a1 = 0.f, a2 = 0.f, a3 = 0.f;
          const float* pw = F.pool_w + (size_t)g * 128 * 128 + d; LAS const float* wl = win + 128 * g;
#pragma unroll 16
          for (int cc = 0; cc < 128; ++cc) { const float p = pw[cc * 128]; a0 += wl[cc] * p; a1 += wl[512 + cc] * p; a2 += wl[1024 + cc] * p; a3 += wl[1536 + cc] * p; }
          v2u o; o.x = pk2(a0, a1); o.y = pk2(a2, a3);
          *(v2u*)(F.WIN + (size_t)(1024 + tid) * D + 4 * it) = o; }
        __syncthreads();
    }
    for (int gt = blockIdx.x * NTHREADS + tid; gt < 64 * 17 * 64; gt += F.G * NTHREADS) {
        const int l = gt & 63, s = (gt >> 6) % 17, un = gt / (64 * 17), h = un >> 3, o = un & 7, m = l & 31, kk0 = 8 * (l >> 5);
        float v[8];
#pragma unroll
        for (int jj = 0; jj < 8; ++jj) { const int kk = kk0 + jj; float val = 0.f;
            if (s < 16) { const int tap = s >> 2, i = 16 * (s & 3) + kk; const float cw = F.conv_w[tap * LRU + 64 * h + i];
                if (m < 8) val = cw * F.gaw[(size_t)(h * 64 + i) * 64 + 8 * o + m];
                else if (m < 16) val = cw * F.gxw[(size_t)(h * 64 + i) * 64 + 8 * o + m - 8];
                else if (m < 24) val = (i == 8 * o + m - 16) ? cw : 0.f;
            } else if (m >= 24) val = (kk == 8 * (o & 1) + m - 24) ? 1.0f : 0.f;
            v[jj] = val; }
        v4u w; w.x = pk2(v[0], v[1]); w.y = pk2(v[2], v[3]); w.z = pk2(v[4], v[5]); w.w = pk2(v[6], v[7]);
        *(v4u*)(F.GT + (size_t)gt * 8) = w;
    }
    for (int ch = blockIdx.x * NWAVES + F.wave; ch < LRU; ch += F.G * NWAVES) {
        const int h = ch >> 6, jn = ch & 63; const float cb = F.conv_b[64 * h + lane];
        const float sa = wave_sum(cb * F.gaw[(size_t)(h * 64 + lane) * 64 + jn]), sx = wave_sum(cb * F.gxw[(size_t)(h * 64 + lane) * 64 + jn]);
        if (lane == 0) { const float lm = F.lam[ch]; const float sp = log1pf(__expf(-lm));
            f32x4 o; o[0] = sa + F.gab[ch]; o[1] = sx + F.gxb[ch]; o[2] = F.conv_b[ch]; o[3] = -8.0f * sp * LOG2E;
            *(f32x4*)(F.CT + 4 * ch) = o; }
    }
    {
        LAS float* scr = (LAS float*)(F.lds + F.wave * 8448);
        const int gw = F.vcu * NWAVES + F.wave, NGW = F.G * NWAVES;
        constexpr int NITEMS = 512 + 512;
        TrJob j; int item = 0; f32x4 v[8];
        for (int it = gw; it < NITEMS; it += NGW) {
            if (!tr_job(F, it, j, item)) break;
            tr_load(j, item, lane, v); tr_put(scr, lane, v);
            LDS_WAIT(); asm volatile("" ::: "memory");
            tr_store(j, item, lane, scr);
            LDS_WAIT(); asm volatile("" ::: "memory");
        }
    }
    __syncthreads();
    { f32x4 sva[16]; p0_strips<0, false>(F, F.vcu, F.G, NS_P0, sva); }
}

__device__ __forceinline__ void p1_prenorm(Frame& F) {
    LAS float* cH = (LAS float*)F.lds; LAS float* sh = cH + D;
    for (int rb = F.vcu; rb < T / 64; rb += F.G) {
        const int row0 = 64 * rb, b = row0 / SEQ;
        __syncthreads();
        for (int i = F.tid; i < D; i += NTHREADS) { cH[i] = F.g_mix_pre[i] * (1.0f + modv(F, b, D + i)); sh[i] = modv(F, b, i); }
        __syncthreads();
        for (int j = 0; j < 8; ++j) {
            const int row = row0 + 8 * F.wave + j; const f32x4* xr = (const f32x4*)(F.x + (size_t)row * D) + F.lane;
            f32x4 v[4]; float ss = 0.f;
#pragma unroll
            for (int q = 0; q < 4; ++q) { v[q] = xr[64 * q]; ss += (v[q][0] * v[q][0] + v[q][1] * v[q][1]) + (v[q][2] * v[q][2] + v[q][3] * v[q][3]); }
            const float rstd = rsqrtf(wave_sum(ss) * (1.0f / D) + EPS);
            v2u* o8 = (v2u*)(F.H + (size_t)row * D) + F.lane;
#pragma unroll
            for (int q = 0; q < 4; ++q) { const f32x4 cc = *(LAS const f32x4*)(cH + 4 * F.lane + 256 * q), ss4 = *(LAS const f32x4*)(sh + 4 * F.lane + 256 * q);
                const f32x4 hv = v[q] * rstd * cc + ss4; v2u w; w.x = pk2(hv[0], hv[1]); w.y = pk2(hv[2], hv[3]); o8[64 * q] = w; }
        }
    }
}

template <int WD> __device__ __forceinline__ void pool_run(const bf16* vp, bf16* op, int t, const float (&pb)[8], const float (&ps)[8]) {
    constexpr int NR = WD + 7;
    v4u r[NR];
#pragma unroll
    for (int k = 0; k < NR; ++k) { r[k] = (v4u){0u, 0u, 0u, 0u}; if (t - (WD - 1) + k >= 0) r[k] = *(const v4u*)(vp + (long)(k - (WD - 1)) * INW); }
    float s[8] = {0.f, 0.f, 0.f, 0.f, 0.f, 0.f, 0.f, 0.f};
#pragma unroll
    for (int k = 0; k < WD - 1; ++k) { if ((k & 3) == 3) __builtin_amdgcn_sched_barrier(0); s[0] += bf_lo(r[k].x); s[1] += bf_hi(r[k].x); s[2] += bf_lo(r[k].y); s[3] += bf_hi(r[k].y); s[4] += bf_lo(r[k].z); s[5] += bf_hi(r[k].z); s[6] += bf_lo(r[k].w); s[7] += bf_hi(r[k].w); }
#pragma unroll
    for (int i = 0; i < 8; ++i) {
        const v4u q = r[WD - 1 + i];
        const float cv[8] = {bf_lo(q.x), bf_hi(q.x), bf_lo(q.y), bf_hi(q.y), bf_lo(q.z), bf_hi(q.z), bf_lo(q.w), bf_hi(q.w)};
        const int cnt = (t + i + 1) < WD ? (t + i + 1) : WD; const float rc = 1.0f / (float)cnt;
        float ov[8];
#pragma unroll
        for (int x = 0; x < 8; ++x) { s[x] += cv[x]; ov[x] = (s[x] * rc - cv[x] + pb[x]) * ps[x]; }
        v4u ow; ow.x = pk2(ov[0], ov[1]); ow.y = pk2(ov[2], ov[3]); ow.z = pk2(ov[4], ov[5]); ow.w = pk2(ov[6], ov[7]);
        *(v4u*)(op + (size_t)i * D) = ow;
        const v4u z = r[i];
        s[0] -= bf_lo(z.x); s[1] -= bf_hi(z.x); s[2] -= bf_lo(z.y); s[3] -= bf_hi(z.y); s[4] -= bf_lo(z.z); s[5] -= bf_hi(z.z); s[6] -= bf_lo(z.w); s[7] -= bf_hi(z.w);
        __builtin_amdgcn_sched_barrier(0);
    }
}
constexpr int XS_PITCH = 144, P3_AB = 74752, P3_YS = 123904;
__device__ __forceinline__ void p3_mixer(Frame& F) {
    const int tid = F.tid, lane = F.lane, w = F.wave, hh = lane >> 5, tl = lane & 31;
    LAS unsigned char* XS = F.lds;
    LAS float* ABa = (LAS float*)(F.lds + P3_AB); LAS float* ABb = ABa + 8 * 512; LAS float* ABg = ABb + 8 * 512;
    LAS bf16* YS = (LAS bf16*)(F.lds + P3_YS);
    for (int unit = F.vcu; unit < 256; unit += F.G) {
        const int b = unit >> 6, h = (unit >> 3) & 7, o = unit & 7;
        bf16x8 Af[17];
        { const bf16x8* gt = (const bf16x8*)F.GT + (size_t)((h * 8 + o) * 17) * 64 + lane;
#pragma unroll
          for (int s = 0; s < 17; ++s) Af[s] = gt[s * 64]; }
        float br[4], bi[4], bx[4], kc[4];
#pragma unroll
        for (int x = 0; x < 4; ++x) { const f32x4 c4 = *(const f32x4*)(F.CT + 4 * (64 * h + 8 * o + 4 * hh + x)); br[x] = c4[0]; bi[x] = c4[1]; bx[x] = c4[2]; kc[x] = c4[3]; }
        float carry = 0.f;
        const bf16* Ub = F.U + (size_t)(b * SEQ) * INW;
        __syncthreads();
        if (tid < 24) *(LAS v4u*)(XS + (tid >> 3) * XS_PITCH + (tid & 7) * 16) = (v4u){0u, 0u, 0u, 0u};
        v4u xr[8];
#pragma unroll
        for (int j = 0; j < 8; ++j) { const int p = tid + 512 * j; xr[j] = *(const v4u*)(Ub + (size_t)(p >> 3) * INW + 64 * h + 8 * (p & 7)); }
        for (int ck = 0; ck < 8; ++ck) {
            const int t0 = 512 * ck;
#pragma unroll
            for (int j = 0; j < 8; ++j) { const int p = tid + 512 * j; *(LAS v4u*)(XS + (3 + (p >> 3)) * XS_PITCH + (p & 7) * 16) = xr[j]; }
            bf16x8 gaf[2];
#pragma unroll
            for (int tile = 0; tile < 2; ++tile) gaf[tile] = *(const bf16x8*)(Ub + (size_t)(t0 + 64 * w + 32 * tile + tl) * INW + 512 + 64 * h + 16 * (o >> 1) + 8 * hh);
            __syncthreads();
            if (ck < 7) {
#pragma unroll
                for (int j = 0; j < 8; ++j) { const int p = tid + 512 * j; xr[j] = *(const v4u*)(Ub + (size_t)(t0 + 512 + (p >> 3)) * INW + 64 * h + 8 * (p & 7)); }
            }
#pragma unroll
            for (int tile = 0; tile < 2; ++tile) {
                const int tt = 64 * w + 32 * tile + tl;
                f32x16 acc;
#pragma unroll
                for (int i = 0; i < 16; ++i) acc[i] = 0.f;
#pragma unroll
                for (int s = 0; s < 16; ++s) { const int tap = s >> 2, q = s & 3;
                    const bf16x8 bf = *(LAS const bf16x8*)(XS + (tt + 3 - tap) * XS_PITCH + 32 * q + 16 * hh);
                    acc = __builtin_amdgcn_mfma_f32_32x32x16_bf16(Af[s], bf, acc, 0, 0, 0); if ((s & 3) == 3) __builtin_amdgcn_sched_barrier(0); }
                acc = __builtin_amdgcn_mfma_f32_32x32x16_bf16(Af[16], gaf[tile], acc, 0, 0, 0);
#pragma unroll
                for (int x = 0; x < 4; ++x) {
                    const float r = fast_sigmoid(acc[x] + br[x]), ig = fast_sigmoid(acc[4 + x] + bi[x]), xc = acc[8 + x] + bx[x];
                    const float a = __builtin_amdgcn_exp2f(r * kc[x]);
                    const float mult = __builtin_amdgcn_sqrtf(fmaxf(1.0f - a * a, 0.f));
                    const int idx = (4 * hh + x) * 512 + tt;
                    ABa[idx] = a; ABb[idx] = mult * ig * xc; ABg[idx] = gelu_tanh(acc[12 + x]);
                }
            }
            __syncthreads();
            if (tid < 24) *(LAS v4u*)(XS + (tid >> 3) * XS_PITCH + (tid & 7) * 16) = *(LAS const v4u*)(XS + (512 + (tid >> 3)) * XS_PITCH + (tid & 7) * 16);
            {
                const f32x4 a0 = *(LAS const f32x4*)(ABa + w * 512 + 8 * lane), a1 = *(LAS const f32x4*)(ABa + w * 512 + 8 * lane + 4);
                const f32x4 b0 = *(LAS const f32x4*)(ABb + w * 512 + 8 * lane), b1 = *(LAS const f32x4*)(ABb + w * 512 + 8 * lane + 4);
                const f32x4 g0 = *(LAS const f32x4*)(ABg + w * 512 + 8 * lane), g1 = *(LAS const f32x4*)(ABg + w * 512 + 8 * lane + 4);
                float av[8] = {a0[0], a0[1], a0[2], a0[3], a1[0], a1[1], a1[2], a1[3]}, bv[8] = {b0[0], b0[1], b0[2], b0[3], b1[0], b1[1], b1[2], b1[3]};
                float gv[8] = {g0[0], g0[1], g0[2], g0[3], g1[0], g1[1], g1[2], g1[3]};
                float hl[8], pc[8]; float hcur = 0.f, pcur = 1.f;
#pragma unroll
                for (int i = 0; i < 8; ++i) { hcur = av[i] * hcur + bv[i]; pcur *= av[i]; hl[i] = hcur; pc[i] = pcur; }
                float A = pcur, B = hcur;
#pragma unroll
                for (int d = 1; d < 64; d <<= 1) { const float Ap = __shfl_up(A, d), Bp = __shfl_up(B, d); if (lane >= d) { B = A * Bp + B; A = A * Ap; } }
                float Ae = __shfl_up(A, 1), Be = __shfl_up(B, 1); if (lane == 0) { Ae = 1.f; Be = 0.f; }
                const float hin = Ae * carry + Be;
                float hv[8];
#pragma unroll
                for (int i = 0; i < 8; ++i) hv[i] = hl[i] + pc[i] * hin;
                carry = __shfl(hv[7], 63);
                { v4u yw; yw.x = pk2(hv[0] * gv[0], hv[1] * gv[1]); yw.y = pk2(hv[2] * gv[2], hv[3] * gv[3]); yw.z = pk2(hv[4] * gv[4], hv[5] * gv[5]); yw.w = pk2(hv[6] * gv[6], hv[7] * gv[7]);
                  *(LAS v4u*)(YS + w * 512 + 8 * lane) = yw; }
            }
            __syncthreads();
            { unsigned y[8];
#pragma unroll
              for (int c8 = 0; c8 < 8; ++c8) y[c8] = YS[c8 * 512 + tid];
              v4u ow; ow.x = y[0] | (y[1] << 16); ow.y = y[2] | (y[3] << 16); ow.z = y[4] | (y[5] << 16); ow.w = y[6] | (y[7] << 16);
              *(v4u*)(F.MIXIN + (size_t)(b * SEQ + t0 + tid) * D + 64 * h + 8 * o) = ow; }
        }
    }
    for (int it = F.vcu; it < 256; it += F.G) {
        int lv = lane; asm volatile("" : "+v"(lv));
        const int g = w & 3, cg = 16 * g + (lv & 15), run = it * 8 + (w >> 2) * 4 + (lv >> 4), row0 = 8 * run, t = row0 & (SEQ - 1);
        const bf16* vp = F.U + (size_t)row0 * INW + 1024 + 8 * cg; bf16* op = F.MIXIN + (size_t)row0 * D + 512 + 8 * cg;
        float pb[8], ps[8];
        { const f32x4 pb0 = *(const f32x4*)(F.pool_b + 8 * cg), pb1 = *(const f32x4*)(F.pool_b + 8 * cg + 4), ps0 = *(const f32x4*)(F.pool_s + 8 * cg), ps1 = *(const f32x4*)(F.pool_s + 8 * cg + 4);
#pragma unroll
          for (int x = 0; x < 4; ++x) { pb[x] = pb0[x]; pb[4 + x] = pb1[x]; ps[x] = ps0[x]; ps[4 + x] = ps1[x]; } }
        if (g == 0) pool_run<2>(vp, op, t, pb, ps); else if (g == 1) pool_run<4>(vp, op, t, pb, ps); else if (g == 2) pool_run<8>(vp, op, t, pb, ps); else pool_run<16>(vp, op, t, pb, ps);
    }
}

constexpr int P5_HL_PITCH = 4112;
constexpr int P5_HL = 0, P5_PART = 16 * P5_HL_PITCH, P5_LOG = P5_PART + 8 * 16 * 32 * 4;
constexpr int P5_VEC = AUX_OFF;
constexpr int P5_MISC = LDSCTL_OFF + 64;
static_assert(P5_MISC + 2304 + 256 <= LDS_BYTES && P5_LOG + 2048 <= RING_BYTES, "LDS map");
__device__ __forceinline__ void p5_rows(Frame& F) {
    const int tid = F.tid, lane = F.lane, w = F.wave;
    LAS unsigned char* HL = F.lds + P5_HL; LAS float* PART = (LAS float*)(F.lds + P5_PART); LAS float* LOG = (LAS float*)(F.lds + P5_LOG);
    LAS float* cA = (LAS float*)(F.lds + P5_VEC); LAS float* cB = cA + D; LAS float* shF = cB + D;
    LAS int* lcnt = (LAS int*)(F.lds + P5_MISC); LAS int* lbase = lcnt + 32; LAS int* rowe = lbase + 32; LAS int* rowr = rowe + 256; LAS float* rows_s = (LAS float*)(rowr + 256);
    bf16x8 Bh[4][2], Bl[4][2];
#pragma unroll
    for (int s4 = 0; s4 < 4; ++s4)
#pragma unroll
        for (int nb = 0; nb < 2; ++nb) { unsigned hw[4], lw[4];
#pragma unroll
            for (int jj = 0; jj < 4; ++jj) { const int k = 128 * w + 32 * s4 + 8 * (lane >> 4) + 2 * jj; const float v0 = F.router_w[(size_t)k * NE + 16 * nb + (lane & 15)], v1 = F.router_w[(size_t)(k + 1) * NE + 16 * nb + (lane & 15)];
                const unsigned h = pk2(v0, v1); hw[jj] = h; lw[jj] = pk2(v0 - bf_lo(h), v1 - bf_hi(h)); }
            Bh[s4][nb] = __builtin_bit_cast(bf16x8, (v4u){hw[0], hw[1], hw[2], hw[3]}); Bl[s4][nb] = __builtin_bit_cast(bf16x8, (v4u){lw[0], lw[1], lw[2], lw[3]}); }
    for (int rb = F.vcu; rb < T / 64; rb += F.G) {
        const int row0 = 64 * rb, b = row0 / SEQ;
        __syncthreads();
        for (int i = tid; i < D; i += NTHREADS) { cA[i] = modv(F, b, 2 * D + i) * F.g_mix_post[i]; cB[i] = F.g_ffn_pre[i] * (1.0f + modv(F, b, 4 * D + i)); shF[i] = modv(F, b, 3 * D + i); }
        if (tid < 32) lcnt[tid] = 0;
        __syncthreads();
#pragma unroll 1
        for (int ps = 0; ps < 4; ++ps) {
#pragma unroll
            for (int rr = 0; rr < 2; ++rr) {
                const int rl = 16 * ps + 2 * w + rr, row = row0 + rl;
                float hA[16];
                f32x4 xv[4], mv[4]; float ss = 0.f;
#pragma unroll
                for (int q = 0; q < 4; ++q) { xv[q] = *((const f32x4*)(F.x + (size_t)row * D) + lane + 64 * q); const v2u mw = *((const v2u*)(F.MIX + (size_t)row * D) + lane + 64 * q);
                    mv[q] = (f32x4){bf_lo(mw.x), bf_hi(mw.x), bf_lo(mw.y), bf_hi(mw.y)}; ss += (mv[q][0] * mv[q][0] + mv[q][1] * mv[q][1]) + (mv[q][2] * mv[q][2] + mv[q][3] * mv[q][3]); }
                const float rs = rsqrtf(wave_sum(ss) * (1.0f / D) + EPS); float s1 = 0.f;
#pragma unroll
                for (int q = 0; q < 4; ++q) { const f32x4 ca = *(LAS const f32x4*)(cA + 4 * lane + 256 * q); xv[q] = xv[q] + ca * (mv[q] * rs);
                    { v2u xw; xw.x = pk2(xv[q][0], xv[q][1]); xw.y = pk2(xv[q][2], xv[q][3]); *((v2u*)(F.X1 + (size_t)row * D) + lane + 64 * q) = xw; } s1 += (xv[q][0] * xv[q][0] + xv[q][1] * xv[q][1]) + (xv[q][2] * xv[q][2] + xv[q][3] * xv[q][3]); }
                const float r1 = rsqrtf(wave_sum(s1) * (1.0f / D) + EPS);
#pragma unroll
                for (int q = 0; q < 4; ++q) { const f32x4 cb = *(LAS const f32x4*)(cB + 4 * lane + 256 * q), sf = *(LAS const f32x4*)(shF + 4 * lane + 256 * q);
                    const f32x4 hv = xv[q] * r1 * cb + sf;
                    hA[4 * q + 0] = hv[0]; hA[4 * q + 1] = hv[1]; hA[4 * q + 2] = hv[2]; hA[4 * q + 3] = hv[3]; }
                float am = 0.f;
#pragma unroll
                for (int i = 0; i < 16; ++i) am = fmaxf(am, fabsf(hA[i]));
#pragma unroll
                for (int o = 1; o < 64; o <<= 1) am = fmaxf(am, __shfl_xor(am, o));
                const float sc = am > 0.f ? am * (1.0f / 448.0f) : 1.0f, iv = 1.0f / sc;
                if (lane == 0) rows_s[rl] = sc;
                LAS unsigned char* hr = HL + (2 * w + rr) * P5_HL_PITCH + 8 * lane;
#pragma unroll
                for (int q = 0; q < 4; ++q) { *((unsigned*)(F.H2 + (size_t)row * D) + lane + 64 * q) = pk4_fp8(hA[4 * q] * iv, hA[4 * q + 1] * iv, hA[4 * q + 2] * iv, hA[4 * q + 3] * iv);
                    const unsigned h0 = pk2(hA[4 * q], hA[4 * q + 1]), h1 = pk2(hA[4 * q + 2], hA[4 * q + 3]);
                    const unsigned l0 = pk2(hA[4 * q] - bf_lo(h0), hA[4 * q + 1] - bf_hi(h0)), l1 = pk2(hA[4 * q + 2] - bf_lo(h1), hA[4 * q + 3] - bf_hi(h1));
                    *(LAS v2u*)(hr + 512 * q) = (v2u){h0, h1}; *(LAS v2u*)(hr + 2048 + 512 * q) = (v2u){l0, l1}; }
            }
            __syncthreads();
            {   f32x4 acc0 = {0.f, 0.f, 0.f, 0.f}, acc1 = acc0;
                LAS const unsigned char* ap = HL + (lane & 15) * P5_HL_PITCH + 2 * (128 * w + 8 * (lane >> 4));
#pragma unroll
                for (int s4 = 0; s4 < 4; ++s4) { const bf16x8 ah = *(LAS const bf16x8*)(ap + 64 * s4), al = *(LAS const bf16x8*)(ap + 2048 + 64 * s4);
                    acc0 = __builtin_amdgcn_mfma_f32_16x16x32_bf16(ah, Bh[s4][0], acc0, 0, 0, 0); acc1 = __builtin_amdgcn_mfma_f32_16x16x32_bf16(ah, Bh[s4][1], acc1, 0, 0, 0);
                    acc0 = __builtin_amdgcn_mfma_f32_16x16x32_bf16(ah, Bl[s4][0], acc0, 0, 0, 0); acc1 = __builtin_amdgcn_mfma_f32_16x16x32_bf16(ah, Bl[s4][1], acc1, 0, 0, 0);
                    acc0 = __builtin_amdgcn_mfma_f32_16x16x32_bf16(al, Bh[s4][0], acc0, 0, 0, 0); acc1 = __builtin_amdgcn_mfma_f32_16x16x32_bf16(al, Bh[s4][1], acc1, 0, 0, 0); }
#pragma unroll
                for (int rg = 0; rg < 4; ++rg) { LAS float* pp = PART + (w * 16 + 4 * (lane >> 4) + rg) * 32 + (lane & 15); pp[0] = acc0[rg]; pp[16] = acc1[rg]; }
            }
            __syncthreads();
            { float sum = F.router_b[tid & 31];
#pragma unroll
              for (int ww = 0; ww < 8; ++ww) sum += PART[ww * 512 + tid];
              LOG[tid] = sum; }
            __syncthreads();
            {
                const int rl = 16 * ps + 2 * w + (lane >> 5), row = row0 + rl, me = lane & 31;
                float val = LOG[(2 * w + (lane >> 5)) * 32 + me];
                float tv[4]; int te[4];
#pragma unroll
                for (int k = 0; k < 4; ++k) { float m = val; int mi = me;
#pragma unroll
                    for (int d = 1; d < 32; d <<= 1) { const float om = __shfl_xor(m, d); const int oi = __shfl_xor(mi, d); if (om > m || (om == m && oi < mi)) { m = om; mi = oi; } }
                    tv[k] = m; te[k] = mi; if (me == mi) val = -3.0e38f; }
                const float e1 = __expf(tv[1] - tv[0]), e2 = __expf(tv[2] - tv[0]), e3 = __expf(tv[3] - tv[0]); const float inv = 1.0f / (1.0f + e1 + e2 + e3);
                if (me == 0) {
                    const float gts[4] = {inv, e1 * inv, e2 * inv, e3 * inv};
#pragma unroll
                    for (int k = 0; k < 4; ++k) { const int lr = __hip_atomic_fetch_add(lcnt + te[k], 1, __ATOMIC_RELAXED, __HIP_MEMORY_SCOPE_WORKGROUP); rowe[4 * rl + k] = te[k]; rowr[4 * rl + k] = lr; F.gate[(size_t)row * 4 + k] = gts[k]; }
                }
            }
        }
        __syncthreads();
        if (tid < 32) { const int n = lcnt[tid]; lbase[tid] = n ? (int)__hip_atomic_fetch_add((unsigned*)(F.ctl + CW_CNT + 64 * tid), (unsigned)n, RLX_AGENT) : 0; }
        __syncthreads();
        if (tid < 256) { const int e = rowe[tid], rank = lbase[e] + rowr[tid], row = row0 + (tid >> 2);
            F.list[(size_t)e * LISTCAP + rank] = row; F.scl[(size_t)e * LISTCAP + rank] = rows_s[tid >> 2]; F.slot[(size_t)row * 4 + (tid & 3)] = ((unsigned)e << 16) | (unsigned)rank; }
    }
}

__device__ __forceinline__ int moe_setup(Frame& F, int NT) {
    LAS int* aux = (LAS int*)(F.lds + AUX_OFF);
    __syncthreads();
    if (F.tid < 32) aux[F.tid] = (int)__hip_atomic_load((unsigned*)(F.ctl + CW_CNT + 64 * F.tid), RLX_AGENT);
    __syncthreads();
    if (F.tid == 0) { int tp = 0; for (int e = 0; e < NE; ++e) { aux[32 + e] = tp; tp += (aux[e] + 255) >> 8; } aux[64] = tp; }
    __syncthreads();
    const int total = aux[64] * NT;
    if (F.tid < 64) { const long L = (long)F.tid * F.G + F.vcu; int e = -1, mt = 0, mg = 0, pn = 0;
        if (L < total) { mg = (int)(L / NT); pn = (int)(L % NT); e = 0; for (int q = 1; q < NE; ++q) if (aux[32 + q] <= mg) e = q; mt = mg - aux[32 + e]; }
        aux[128 + 4 * F.tid + 0] = e; aux[128 + 4 * F.tid + 1] = mt; aux[128 + 4 * F.tid + 2] = mg; aux[128 + 4 * F.tid + 3] = pn; }
    __syncthreads();
    int n = 0; for (int i = 0; i < 64; ++i) if (aux[128 + 4 * i] >= 0) n = i + 1;
    return __builtin_amdgcn_readfirstlane(n);
}

__device__ __forceinline__ void p8_final(Frame& F) {
    LAS float* cF = (LAS float*)F.lds; LAS int* aux = (LAS int*)(F.lds + AUX_OFF);
    __syncthreads();
    if (F.tid < 32) aux[F.tid] = (int)__hip_atomic_load((unsigned*)(F.ctl + CW_CNT + 64 * F.tid), RLX_AGENT);
    __syncthreads();
    if (F.tid == 0) { int tp = 0; for (int e = 0; e < NE; ++e) { aux[32 + e] = tp; tp += (aux[e] + 255) >> 8; } }
    for (int rb = F.vcu; rb < T / 64; rb += F.G) {
        const int row0 = 64 * rb, b = row0 / SEQ;
        __syncthreads();
        for (int i = F.tid; i < D; i += NTHREADS) cF[i] = modv(F, b, 5 * D + i) * F.g_ffn_post[i];
        __syncthreads();
        for (int j = 0; j < 8; ++j) {
            const int row = row0 + 8 * F.wave + j;
            const v4u sl = *(const v4u*)(F.slot + (size_t)row * 4); const f32x4 gt = *(const f32x4*)(F.gate + (size_t)row * 4);
            const unsigned sv[4] = {sl.x, sl.y, sl.z, sl.w};
            float f[16];
#pragma unroll
            for (int i = 0; i < 16; ++i) f[i] = 0.f;
#pragma unroll
            for (int k = 0; k < 4; ++k) { const int e = (int)(sv[k] >> 16), pos = 256 * aux[32 + e] + (int)(sv[k] & 0xffffu);
                const v4u y = *((const v4u*)(F.Y + (size_t)pos * 1024) + F.lane); const float gk = gt[k] * F.YSC[(size_t)pos * 16 + (F.lane >> 2)];
                const unsigned yw[4] = {y.x, y.y, y.z, y.w};
#pragma unroll
                for (int q = 0; q < 4; ++q) { const f32x2 lo2 = __builtin_amdgcn_cvt_pk_f32_fp8((int)yw[q], false), hi2 = __builtin_amdgcn_cvt_pk_f32_fp8((int)yw[q], true);
                    f[4 * q + 0] += gk * lo2.x; f[4 * q + 1] += gk * lo2.y; f[4 * q + 2] += gk * hi2.x; f[4 * q + 3] += gk * hi2.y; } }
            float ss = 0.f;
#pragma unroll
            for (int i = 0; i < 16; ++i) ss += f[i] * f[i];
            const float rs = rsqrtf(wave_sum(ss) * (1.0f / D) + EPS);
            const v4u xa = *((const v4u*)(F.X1 + (size_t)row * D) + 2 * F.lane), xb2 = *((const v4u*)(F.X1 + (size_t)row * D) + 2 * F.lane + 1);
            const unsigned xw[8] = {xa.x, xa.y, xa.z, xa.w, xb2.x, xb2.y, xb2.z, xb2.w};
#pragma unroll
            for (int q = 0; q < 4; ++q) { const int col = 16 * F.lane + 4 * q; const f32x4 cf = *(LAS const f32x4*)(cF + col);
                const f32x4 x1 = {bf_lo(xw[2 * q]), bf_hi(xw[2 * q]), bf_lo(xw[2 * q + 1]), bf_hi(xw[2 * q + 1])};
                const f32x4 fv = {f[4 * q], f[4 * q + 1], f[4 * q + 2], f[4 * q + 3]};
                *(f32x4*)(F.out2 + (size_t)row * D + col) = x1 + cf * (fv * rs); }
        }
    }
}

struct Args { const float* in[26]; float* out; float* out2; unsigned char* ws; int ph_lo, ph_hi; };
__global__ void __launch_bounds__(NTHREADS, 2) fwd_kernel(Args args) {
    extern __shared__ __attribute__((aligned(16))) unsigned char lds[];
    Frame F;
    F.lds = (LAS unsigned char*)lds;
    F.tid = threadIdx.x; F.lane = F.tid & 63; F.wave = __builtin_amdgcn_readfirstlane(F.tid >> 6);
    F.G = gridDim.x; { const int bx = blockIdx.x; F.vcu = (F.G % 8 == 0) ? (bx % 8) * (F.G / 8) + bx / 8 : bx; }
    unsigned char* ws = args.ws;
    F.ctl = (gu32*)(ws + WS_CTL); F.ws = ws;
    F.x = args.in[0]; F.c = args.in[1]; F.w_ada = args.in[2]; F.b_ada = args.in[3]; F.g_mix_pre = args.in[4]; F.g_mix_post = args.in[5]; F.w_in = args.in[6];
    F.conv_w = args.in[7]; F.conv_b = args.in[8]; F.gaw = args.in[9]; F.gab = args.in[10]; F.gxw = args.in[11]; F.gxb = args.in[12]; F.lam = args.in[13];
    F.pool_w = args.in[14]; F.pool_b = args.in[15]; F.pool_s = args.in[16]; F.w_out = args.in[17]; F.g_ffn_pre = args.in[18]; F.g_ffn_post = args.in[19];
    F.router_w = args.in[20]; F.router_b = args.in[21]; F.w1 = args.in[22]; F.b1 = args.in[23]; F.w2 = args.in[24]; F.b2 = args.in[25];
    F.out = args.out; F.out2 = args.out2;
    F.modp = (float*)(ws + WS_MODP); F.CT = (float*)(ws + WS_CT); F.gate = (float*)(ws + WS_GATE); F.GT = (bf16*)(ws + WS_GT); F.WIN = (bf16*)(ws + WS_WIN); F.WOUT = (bf16*)(ws + WS_WOUT);
    F.H = (bf16*)(ws + WS_H); F.U = (bf16*)(ws + WS_U); F.MIXIN = (bf16*)(ws + WS_MIXIN); F.MIX = (bf16*)(ws + WS_MIX); F.X1 = (bf16*)(ws + WS_X1); F.H2 = ws + WS_H2;
    F.W1T = ws + WS_W1; F.W2T = ws + WS_W2; F.ACT = ws + WS_ACT; F.Y = ws + WS_Y; F.YSC = (float*)(ws + WS_YSC); F.sW1 = (float*)(ws + WS_SW1); F.sW2 = (float*)(ws + WS_SW2); F.scl = (float*)(ws + WS_SCL); F.slot = (unsigned*)(ws + WS_SLOT); F.list = (int*)(ws + WS_LIST);
    for (int u = F.tid; u < (LDS_BYTES - LDSCTL_OFF) / 4; u += NTHREADS) ((LAS unsigned*)(F.lds + LDSCTL_OFF))[u] = 0u;
    __syncthreads();
    XcdBarrier bar; bar.bar = (unsigned*)(F.ctl + CW_BAR); bar.x = 0; bar.st = nullptr;
    if (N_LAUNCHES == 1) bar = xcd_barrier_post((unsigned*)(F.ctl + CW_BAR), (volatile LAS unsigned*)(F.lds + LDSCTL_OFF));
    const int lo = args.ph_lo, hi = args.ph_hi;
#ifndef PH_MASK
#define PH_MASK 0x1ff
#endif
#define IN(k) (((PH_MASK >> (k)) & 1) && lo <= (k) && (k) < hi)
#define SEAM(k) do { if (IN(k) && IN((k) + 1)) xcd_barrier(bar); } while (0)

#ifdef PROBE_EXP
    if (lo >= 100) { return; }
#endif
    if (IN(0)) { p0_prologue(F); SEAM(0); }
    if (IN(1)) { p1_prenorm(F); SEAM(1); }
    if (IN(2)) {
        pg8::StaticSched S; S.init(F.WIN, T, INW, D, F.G, (int)blockIdx.x);
        pg8::EpiBf16 E{F.U, INW, nullptr, 0};
        pg8::gemm_phase<pg8::EpiBf16, pg8::StaticSched>(F.lds, (const char*)F.H, D, S, E);
        if (F.G == 256 && blockIdx.x >= 128) { __syncthreads(); f32x4 sva[16]; p0_strips<0, false>(F, NS_P0 + ((int)blockIdx.x - 128), 128, NSTRIPS_ALL, sva); }
        else if (F.G != 256 && blockIdx.x == 0) { __syncthreads(); f32x4 sva[16]; p0_strips<0, false>(F, NS_P0, 1, NSTRIPS_ALL, sva); }
        SEAM(2);
    }
    if (IN(3)) { p3_mixer(F); SEAM(3); }
    if (IN(4)) {
        pg8::StaticSched S; S.init(F.WOUT, T, D, D, F.G, (int)blockIdx.x);
        pg8::EpiBf16 E{F.MIX, D, nullptr, 0};
        pg8::gemm_phase<pg8::EpiBf16, pg8::StaticSched>(F.lds, (const char*)F.MIXIN, D, S, E);
        SEAM(4);
    }
    if (IN(5)) { p5_rows(F); SEAM(5); }
    if (IN(6)) {
        const int nu = moe_setup(F, 8);
        LAS const int* aux = (LAS const int*)(F.lds + AUX_OFF);
        pg8::MoeSched<true> S{(const char*)F.W1T, (size_t)DE2 * 1024, aux + 128, aux, F.list, nu};
        pg8::EpiSwiglu8 E{F.ACT, F.b1, F.sW1, F.scl, aux};
        pg8::gemm_phase<pg8::EpiSwiglu8, pg8::MoeSched<true>>(F.lds, (const char*)F.H2, 512, S, E);
        SEAM(6);
    }
    if (IN(7)) {
        const int nu = moe_setup(F, 4);
        LAS const int* aux = (LAS const int*)(F.lds + AUX_OFF);
        pg8::MoeSched<false> S{(const char*)F.W2T, (size_t)D * 1024, aux + 128, aux, F.list, nu};
        pg8::EpiY8 E{F.Y, F.YSC, F.b2, F.sW2};
        pg8::gemm_phase<pg8::EpiY8, pg8::MoeSched<false>>(F.lds, (const char*)F.ACT, 512, S, E);
        SEAM(7);
    }
    if (IN(8)) { p8_final(F); }
#undef IN
#undef SEAM
}

extern "C" void kernel_launch(void* const* d_in, const int* in_sizes, int n_in, void* d_out, int out_size, void* d_ws, size_t ws_size, hipStream_t stream) {
    static int grid = 0;
    if (grid == 0) {
        if (n_in != 26 || out_size != T * D || ws_size < WS_END) { fprintf(stderr, "kernel_launch: unexpected shapes (n_in %d, out %d, ws %zu); nothing launched\n", n_in, out_size, ws_size); grid = -1; return; }
        int dev = 0, cus = 0, per_cu = 0;
        if (hipGetDevice(&dev) != hipSuccess || hipDeviceGetAttribute(&cus, hipDeviceAttributeMultiprocessorCount, dev) != hipSuccess) { grid = -1; return; }
        if (hipFuncSetAttribute((const void*)fwd_kernel, hipFuncAttributeMaxDynamicSharedMemorySize, LDS_BYTES) != hipSuccess) { fprintf(stderr, "kernel_launch: hipFuncSetAttribute failed\n"); grid = -1; return; }
        if (hipOccupancyMaxActiveBlocksPerMultiprocessor(&per_cu, (const void*)fwd_kernel, NTHREADS, LDS_BYTES) != hipSuccess || per_cu < 1) { fprintf(stderr, "kernel_launch: occupancy query says %d blocks per CU\n", per_cu); (void)hipGetLastError(); grid = -1; return; }
        grid = cus;
        if (grid > 256) grid = 256;
    }
    if (grid < 0) return;
    (void)hipMemsetAsync((char*)d_ws + WS_CTL, 0, CTL_ZERO_BYTES, stream);
    Args a{};
    for (int i = 0; i < 26; ++i) a.in[i] = (const float*)d_in[i];
    a.out = (float*)d_out; a.out2 = (float*)d_out; a.ws = (unsigned char*)d_ws;
#ifdef PROBE_EXP
    { a.ph_lo = PROBE_EXP; a.ph_hi = PROBE_EXP + 1; hipLaunchKernelGGL(fwd_kernel, dim3(grid), dim3(NTHREADS), LDS_BYTES, stream, a); }
#endif
    for (int li = 0; li < N_LAUNCHES; ++li) {
        a.ph_lo = (N_LAUNCHES == 1) ? 0 : li; a.ph_hi = (N_LAUNCHES == 1) ? N_PHASES : li + 1;
#ifdef PROBE_DUP
        if (N_LAUNCHES > 1 && li == 8 && ((PROBE_DUP >> li) & 1)) { a.out2 = (float*)((char*)d_ws + WS_END); hipLaunchKernelGGL(fwd_kernel, dim3(grid), dim3(NTHREADS), LDS_BYTES, stream, a); a.out2 = (float*)d_out; hipLaunchKernelGGL(fwd_kernel, dim3(grid), dim3(NTHREADS), LDS_BYTES, stream, a); continue; }
#endif
        hipLaunchKernelGGL(fwd_kernel, dim3(grid), dim3(NTHREADS), LDS_BYTES, stream, a);
#ifdef PROBE_DUP
        if (N_LAUNCHES > 1 && ((PROBE_DUP >> li) & 1)) {
            if (li == 5) (void)hipMemsetAsync((char*)d_ws + WS_CTL, 0, CTL_ZERO_BYTES, stream);
            hipLaunchKernelGGL(fwd_kernel, dim3(grid), dim3(NTHREADS), LDS_BYTES, stream, a);
        }
#endif
    }
}
```
